# Optimizing an MI355X kernel written in HIP

```python
import math
import jax, jax.numpy as jnp
from jax import lax
import numpy as np

D_MODEL = 1024
BATCH = 16
SEQ = 2048
DEPTH = 2

MEM_LEN = 256
ATTN_WIDTH = D_MODEL // 2
CONV_WIDTH_CH = D_MODEL - ATTN_WIDTH
DIFF_HEAD_DIM = 64
DIFF_HEADS = ATTN_WIDTH // (2 * DIFF_HEAD_DIM)
CONV_K = 3
CONV_GROUPS = 4
ROT_DIM = DIFF_HEAD_DIM // 4
ROPE_THETA = 500000.0
X_HEADS = 4
X_HEAD_DIM = D_MODEL // X_HEADS
D_FF = 4 * D_MODEL
Q_BLOCK = 128
NEG_INF = -1e30
NORM_EPS = 1e-6
SUBLN_EPS = 1e-5
IN_COLS = 3 * ATTN_WIDTH + 3 * CONV_WIDTH_CH

kernel_name = "hybrid_diffattn_shortconv_block"


def rms_norm(x, g, eps=NORM_EPS):
    xf = x.astype(jnp.float32)
    y = xf * lax.rsqrt(jnp.mean(xf * xf, axis=-1, keepdims=True) + eps)
    return (y * g.astype(jnp.float32)).astype(x.dtype)


def rotary_tables(positions):
    inv_freq = ROPE_THETA ** (-jnp.arange(0, ROT_DIM, 2, dtype=jnp.float32) / ROT_DIM)
    ang = positions.astype(jnp.float32)[..., None] * inv_freq
    return jnp.cos(ang), jnp.sin(ang)


def apply_partial_rotary(t, cos, sin):
    half = ROT_DIM // 2
    r1 = t[..., :half]
    r2 = t[..., half:ROT_DIM]
    rest = t[..., ROT_DIM:]
    c = cos[:, :, None, None, :].astype(t.dtype)
    s = sin[:, :, None, None, :].astype(t.dtype)
    return jnp.concatenate([r1 * c - r2 * s, r2 * c + r1 * s, rest], axis=-1)


def diff_attention(q, k, v, lam, subln_g, lambda_init):
    bsz, seq = q.shape[0], q.shape[1]
    scale = DIFF_HEAD_DIM ** -0.5
    qh = jnp.transpose(q, (0, 2, 3, 1, 4))
    kh = jnp.transpose(k, (0, 2, 3, 1, 4))
    vh = jnp.transpose(v, (0, 2, 1, 3))
    outs = []
    for start in range(0, seq, Q_BLOCK):
        end = start + Q_BLOCK
        qb = qh[:, :, :, start:end]
        kb = kh[:, :, :, :end]
        vb = vh[:, :, :end]
        s = jnp.einsum('bhcqd,bhckd->bhcqk', qb, kb).astype(jnp.float32) * scale
        mask = (start + jnp.arange(Q_BLOCK))[:, None] >= jnp.arange(end)[None, :]
        s = jnp.where(mask, s, NEG_INF)
        p = jax.nn.softmax(s, axis=-1)
        w = p[:, :, 0] - lam * p[:, :, 1]
        outs.append(jnp.einsum('bhqk,bhkd->bhqd', w.astype(vb.dtype), vb))
    o = jnp.concatenate(outs, axis=2)
    o = rms_norm(o, subln_g, eps=SUBLN_EPS) * (1.0 - lambda_init)
    return jnp.transpose(o, (0, 2, 1, 3)).reshape(bsz, seq, ATTN_WIDTH)


def short_gated_conv(b_gate, c_gate, h, conv_w):
    seq = h.shape[1]
    u = c_gate * h
    up = jnp.pad(u, ((0, 0), (CONV_K - 1, 0), (0, 0)))
    y = conv_w[0] * up[:, 0:seq]
    for j in range(1, CONV_K):
        y = y + conv_w[j] * up[:, j:j + seq]
    return b_gate * y


def cross_attention(xn, memn, w_q, w_kv, w_o):
    bsz, seq = xn.shape[0], xn.shape[1]
    q = (xn @ w_q).reshape(bsz, seq, X_HEADS, X_HEAD_DIM)
    kv = memn @ w_kv
    k = kv[..., :D_MODEL].reshape(bsz, MEM_LEN, X_HEADS, X_HEAD_DIM)
    v = kv[..., D_MODEL:].reshape(bsz, MEM_LEN, X_HEADS, X_HEAD_DIM)
    s = jnp.einsum('bshd,bmhd->bhsm', q, k).astype(jnp.float32) * (X_HEAD_DIM ** -0.5)
    p = jax.nn.softmax(s, axis=-1)
    o = jnp.einsum('bhsm,bmhd->bshd', p.astype(v.dtype), v).reshape(bsz, seq, D_MODEL)
    return o @ w_o


def setup_inputs(seed: int = 0) -> dict:
    key = jax.random.key(seed)
    ks = jax.random.split(key, 24)
    f32 = jnp.float32

    def w(k, shape, fan_in):
        return jax.random.normal(k, shape, f32) * (fan_in ** -0.5)

    def gain(k, shape):
        return 1.0 + 0.02 * jax.random.normal(k, shape, f32)

    x = jax.random.normal(ks[0], (BATCH, SEQ, D_MODEL), f32)
    mem = jax.random.normal(ks[1], (BATCH, MEM_LEN, D_MODEL), f32)
    offset = jax.random.randint(ks[2], (BATCH, 1), 0, 1024, dtype=jnp.int32)
    positions = (offset + jnp.arange(SEQ, dtype=jnp.int32)[None, :]).astype(jnp.int32)
    return {
        "x": x,
        "mem": mem,
        "positions": positions,
        "norm_mix_g": gain(ks[3], (DEPTH, D_MODEL)),
        "w_in": w(ks[4], (DEPTH, D_MODEL, IN_COLS), D_MODEL),
        "lam_q1": 0.1 * jax.random.normal(ks[5], (DEPTH, DIFF_HEAD_DIM), f32),
        "lam_k1": 0.1 * jax.random.normal(ks[6], (DEPTH, DIFF_HEAD_DIM), f32),
        "lam_q2": 0.1 * jax.random.normal(ks[7], (DEPTH, DIFF_HEAD_DIM), f32),
        "lam_k2": 0.1 * jax.random.normal(ks[8], (DEPTH, DIFF_HEAD_DIM), f32),
        "subln_g": gain(ks[9], (DEPTH, 2 * DIFF_HEAD_DIM)),
        "conv_w": w(ks[10], (DEPTH, CONV_K, CONV_WIDTH_CH), CONV_K),
        "w_mix_out": w(ks[11], (DEPTH, D_MODEL, D_MODEL), D_MODEL),
        "norm_x_g": gain(ks[12], (DEPTH, D_MODEL)),
        "mem_norm_g": gain(ks[13], (D_MODEL,)),
        "w_xq": w(ks[14], (DEPTH, D_MODEL, D_MODEL), D_MODEL),
        "w_xkv": w(ks[15], (DEPTH, D_MODEL, 2 * D_MODEL), D_MODEL),
        "w_xo": w(ks[16], (DEPTH, D_MODEL, D_MODEL), D_MODEL),
        "norm_ffn_g": gain(ks[17], (DEPTH, D_MODEL)),
        "w_ff1": w(ks[18], (DEPTH, D_MODEL, D_FF), D_MODEL),
        "w_ff2": w(ks[19], (DEPTH, D_FF, D_MODEL), D_FF),
        "final_g": gain(ks[20], (D_MODEL,)),
    }


def reference(x, mem, positions, norm_mix_g, w_in, lam_q1, lam_k1, lam_q2, lam_k2, subln_g,
              conv_w, w_mix_out, norm_x_g, mem_norm_g, w_xq, w_xkv, w_xo, norm_ffn_g,
              w_ff1, w_ff2, final_g):
    bsz, seq = x.shape[0], x.shape[1]
    cos, sin = rotary_tables(positions)
    memn = rms_norm(mem, mem_norm_g)
    a0, a1, a2, a3 = ATTN_WIDTH, 2 * ATTN_WIDTH, 3 * ATTN_WIDTH, 3 * ATTN_WIDTH + CONV_WIDTH_CH
    a4 = a3 + CONV_WIDTH_CH
    h = x
    for l in range(DEPTH):
        lambda_init = 0.8 - 0.6 * math.exp(-0.3 * l)
        xn = rms_norm(h, norm_mix_g[l])
        proj = xn @ w_in[l]
        q = proj[..., :a0].reshape(bsz, seq, DIFF_HEADS, 2, DIFF_HEAD_DIM)
        k = proj[..., a0:a1].reshape(bsz, seq, DIFF_HEADS, 2, DIFF_HEAD_DIM)
        v = proj[..., a1:a2].reshape(bsz, seq, DIFF_HEADS, 2 * DIFF_HEAD_DIM)
        b_gate = proj[..., a2:a3]
        c_gate = proj[..., a3:a4]
        hc = proj[..., a4:]
        q = apply_partial_rotary(q, cos, sin)
        k = apply_partial_rotary(k, cos, sin)
        lam = (jnp.exp(jnp.sum(lam_q1[l].astype(jnp.float32) * lam_k1[l].astype(jnp.float32)))
               - jnp.exp(jnp.sum(lam_q2[l].astype(jnp.float32) * lam_k2[l].astype(jnp.float32)))
               + lambda_init)
        attn_out = diff_attention(q, k, v, lam, subln_g[l], lambda_init)
        conv_out = short_gated_conv(b_gate, c_gate, hc, conv_w[l])
        mixed = jnp.concatenate([attn_out, conv_out.astype(attn_out.dtype)], axis=-1)
        h = h + mixed @ w_mix_out[l]
        h = h + cross_attention(rms_norm(h, norm_x_g[l]), memn, w_xq[l], w_xkv[l], w_xo[l])
        f = rms_norm(h, norm_ffn_g[l]) @ w_ff1[l]
        f = jnp.square(jax.nn.relu(f))
        h = h + f @ w_ff2[l]
    return rms_norm(h, final_g)
```

```cpp
#include <hip/hip_runtime.h>
#include <hip/hip_bf16.h>
#include <cstdio>
#include <cstdint>
#include <cmath>

#ifndef RES_F32
#define RES_F32 0
#endif
static_assert(RES_F32 == 0, "the tiled residual layout is implemented for the bf16 residual only");
#ifndef MK_PER_PHASE
#define MK_PER_PHASE 0
#endif

constexpr int NB = 16, SEQ = 2048, DM = 1024, MTOK = NB * SEQ, MEML = 256, MMEM = NB * MEML, INC = 3072, FF = 4096, DEPTH = 2;
constexpr float NORM_EPS = 1e-6f, SUBLN_EPS = 1e-5f;
constexpr float LOG2E = 1.4426950408889634f;
constexpr float C2_ATT = 0.125f * LOG2E;
constexpr float C2_X = 0.0625f * LOG2E;

namespace pg8 {
#define PG8_LAS __attribute__((address_space(3)))
typedef unsigned short bf16_t;
typedef short bf16x8 __attribute__((ext_vector_type(8)));
typedef float f32x4 __attribute__((ext_vector_type(4)));
typedef float f32x2 __attribute__((ext_vector_type(2)));
typedef unsigned u32x4 __attribute__((ext_vector_type(4)));
constexpr int BM = 256, BK = 64, HALF = 128, HTB = HALF * BK * 2, STAGE_BYTES = 8 * HTB, NXCD = 8, WGM = 8;

__host__ __device__ __forceinline__ int lds_byte(int r, int c) { const int st = (r >> 4) * 2 + (c >> 5), rr = r & 15, cc = c & 31, ob = rr * 64 + cc * 2; return st * 1024 + (ob ^ (((ob >> 9) & 1) << 5)); }
__host__ __device__ __forceinline__ void stage_rc(int b, int& R, int& C) { const int st = b / 1024, sb = b % 1024, swz = sb ^ (((sb >> 9) & 1) << 5); R = (st >> 1) * 16 + swz / 64; C = (st & 1) * 32 + (swz % 64) / 2; }
__host__ __device__ __forceinline__ int perm32(int rho) { const int n = rho >> 4, i = rho & 15; return 8 * (i >> 2) + 4 * n + (i & 3); }

__host__ __device__ __forceinline__ int invperm32(int p) { return ((p >> 2) & 1) * 16 + (((p >> 3) << 2) | (p & 3)); }
__host__ __device__ __forceinline__ size_t btile_off(int n, int k, int K) {
    const int nt = n >> 8, half = (n >> 7) & 1, nl = n & 127, R = (nl & ~31) + invperm32(nl & 31), kt = k >> 6, C = k & 63;
    return ((size_t)(nt * (K >> 6) + kt) * 2 + half) * 8192 + (size_t)(lds_byte(R, C) >> 1);
}
__host__ __device__ __forceinline__ size_t atile_off(int r256, int k) { return ((size_t)(k >> 6) * 2 + (r256 >> 7)) * 8192 + (size_t)(lds_byte(r256 & 127, k & 63) >> 1); }
struct Unit { int pm, pn, z; };
typedef __attribute__((address_space(1))) unsigned char gbyte;
struct TileAddr { gbyte* b[2][2]; unsigned voff;
    __device__ __forceinline__ void init(void* panel, int pn, int wr, int wc, int fr, int fq) {
        gbyte* p = (gbyte*)panel + (size_t)__builtin_amdgcn_readfirstlane(pn) * 131072;
        b[0][0] = p; b[1][0] = p + 16384; b[0][1] = p + 65536; b[1][1] = p + 81920;
        asm volatile("" : "+s"(b[0][0]), "+s"(b[1][0]), "+s"(b[0][1]), "+s"(b[1][1]));
        voff = (unsigned)((wc >> 1) * 32768 + lds_byte(wr * 64 + fr, (wc & 1) * 32 + 8 * fq) + 4096); }
    __device__ __forceinline__ __attribute__((address_space(1))) u32x4* at(int ai, int bj, int m) const { return (__attribute__((address_space(1))) u32x4*)(b[ai][bj] + (size_t)voff + (m - 2) * 2048); }
};
constexpr size_t XG_EL = (size_t)16 << 20;
constexpr size_t XP_EL = (size_t)1 << 20;
__device__ __forceinline__ size_t xrow(int row, int ld) { return (size_t)(row >> 8) * XP_EL + (size_t)(row & 255) * ld; }

struct Order2D {
    int nM, nN, nwg, G, c, vcu; bool pair;
    __device__ __forceinline__ void init(int nM_, int nN_, int G_, int c_, int vcu_) { nM = nM_; nN = nN_; nwg = nM * nN; G = G_; c = c_; vcu = vcu_; pair = (G_ == 256) && (nM_ == 128) && ((nN_ & 1) == 0); }
    __device__ __forceinline__ bool next(int i, int& pm, int& pn) const {
        if (pair) { if (2 * i >= nN) return false; pm = vcu >> 1; pn = 2 * i + (vcu & 1); return true; }
        const long L = (long)i * G + c; if (L >= nwg) return false;
        int wgid = (int)L; { const int q = nwg / NXCD, r = nwg % NXCD, xcd = wgid % NXCD, off = wgid / NXCD; wgid = (xcd < r ? xcd * (q + 1) : r * (q + 1) + (xcd - r) * q) + off; }
        const int nig = WGM * nN, gid = wgid / nig, fm = gid * WGM, gsz = (nM - fm) < WGM ? (nM - fm) : WGM;
        pm = fm + ((wgid % nig) % gsz); pn = (wgid % nig) / gsz; return true;
    }
};

__device__ __forceinline__ unsigned cvt_pk_bf16(float lo, float hi) { unsigned r; asm volatile("v_cvt_pk_bf16_f32 %0, %1, %2" : "=v"(r) : "v"(lo), "v"(hi)); return r; }

template <class Epi, class Prob, bool ALIGN_EPI, bool SP2>
__device__ __forceinline__ void gemm_phase(PG8_LAS unsigned char* lds, const Prob& S, const Epi& E, const int tid) {
    const int wid = __builtin_amdgcn_readfirstlane(tid >> 6), lane = tid & 63, wr = wid >> 2, wc = wid & 3, fr = lane & 15, fq = lane >> 4;
    const int K = S.K, nt = K / BK;
    unsigned voffA[2], voffB[2];
#pragma unroll
    for (int i = 0; i < 2; ++i) { int R, C; stage_rc(tid * 16 + i * 8192, R, C); const int Rb = (R & ~31) + perm32(R & 31);
        voffA[i] = Prob::ATILED ? (unsigned)(tid * 16 + i * 8192) : (unsigned)(R * S.lda + C) * 2u; voffB[i] = Prob::BTILED ? (unsigned)(tid * 16 + i * 8192) : (unsigned)(Rb * S.ldb + C) * 2u; }
    const size_t kstep = Prob::ATILED ? (size_t)32768 : (size_t)(BK * 2), kstepB = Prob::BTILED ? (size_t)32768 : (size_t)(BK * 2);
    const size_t hstepA = Prob::ATILED ? (size_t)16384 : (size_t)HALF * S.lda * 2, hstepB = Prob::BTILED ? (size_t)16384 : (size_t)HALF * S.ldb * 2;
    const unsigned ldsw = (unsigned)wid * 1024u;
    const int aoff = lds_byte(wr * 64 + fr, fq * 8), boff = lds_byte(wc * 32 + fr, fq * 8);
#define PG8_SA(b, h) (((b) * 2 + (h)) * HTB)
#define PG8_SB(b, h) ((4 + (b) * 2 + (h)) * HTB)
#define PG8_STAGE(bufoff, gbase, voff) do { _Pragma("unroll") for (int _i = 0; _i < 2; ++_i) \
        __builtin_amdgcn_global_load_lds((const unsigned*)((const char*)(gbase) + (voff)[_i]), (PG8_LAS unsigned*)(lds + (bufoff) + ldsw + _i * 8192), 16, 0, 0); } while (0)
#define PG8_LDA(dst, b, h) do { _Pragma("unroll") for (int m = 0; m < 4; ++m) _Pragma("unroll") for (int k = 0; k < 2; ++k) dst[m][k] = *(const PG8_LAS bf16x8*)(lds + PG8_SA(b, h) + aoff + m * 2048 + k * 1024); } while (0)
#define PG8_LDB(dst, b, h) do { _Pragma("unroll") for (int n = 0; n < 2; ++n) _Pragma("unroll") for (int k = 0; k < 2; ++k) dst[n][k] = *(const PG8_LAS bf16x8*)(lds + PG8_SB(b, h) + boff + n * 2048 + k * 1024); } while (0)
#define PG8_MMA(ai, bj, At, Bt) do { __builtin_amdgcn_s_setprio(1); _Pragma("unroll") for (int m = 0; m < 4; ++m) _Pragma("unroll") for (int n = 0; n < 2; ++n) _Pragma("unroll") for (int k = 0; k < 2; ++k) \
        acc[ai][bj][m][n] = __builtin_amdgcn_mfma_f32_16x16x32_bf16(Bt[n][k], At[m][k], acc[ai][bj][m][n], 0, 0, 0); __builtin_amdgcn_s_setprio(0); } while (0)
#define PG8_WAIT_V(n) asm volatile("s_waitcnt vmcnt(" #n ")" ::: "memory")
#define PG8_WAIT_L(n) asm volatile("s_waitcnt lgkmcnt(" #n ")" ::: "memory")
#define PG8_BAR __builtin_amdgcn_s_barrier()
#define PG8_SCHED __builtin_amdgcn_sched_barrier(0)
    Unit cur, nxt; int ui = 0;
    if (!S.next(0, cur)) return;
    typename Epi::Pre pre; E.init(pre); E.prefetch(pre, cur, wr, fr);
    f32x4 acc[2][2][4][2];
#pragma unroll
    for (int a = 0; a < 2; ++a)
#pragma unroll
        for (int b = 0; b < 2; ++b)
#pragma unroll
            for (int m = 0; m < 4; ++m)
#pragma unroll
                for (int n = 0; n < 2; ++n) acc[a][b][m][n] = (f32x4){0.f, 0.f, 0.f, 0.f};
    bf16x8 At[4][2], B0[2][2], B1[2][2];
    const char* cA = S.aptr(cur); const char* cB = S.bptr(cur);
    if constexpr (SP2) {
        PG8_STAGE(PG8_SB(0, 0), cB, voffB); PG8_STAGE(PG8_SB(0, 1), cB + hstepB, voffB); PG8_STAGE(PG8_SA(0, 0), cA, voffA); PG8_STAGE(PG8_SA(0, 1), cA + hstepA, voffA);
        if (wr == 1) PG8_BAR;
        PG8_WAIT_V(2); PG8_BAR;
        PG8_STAGE(PG8_SB(1, 0), cB + kstepB, voffB); PG8_STAGE(PG8_SA(1, 0), cA + kstep, voffA); PG8_STAGE(PG8_SB(1, 1), cB + hstepB + kstepB, voffB);
        PG8_WAIT_V(6); PG8_BAR;
    } else {
        PG8_STAGE(PG8_SB(0, 0), cB, voffB); PG8_STAGE(PG8_SA(0, 0), cA, voffA); PG8_STAGE(PG8_SB(0, 1), cB + hstepB, voffB); PG8_STAGE(PG8_SA(0, 1), cA + hstepA, voffA);
        if (wr == 1) PG8_BAR;
        PG8_WAIT_V(4); PG8_BAR;
        PG8_STAGE(PG8_SB(1, 0), cB + kstepB, voffB); PG8_STAGE(PG8_SA(1, 0), cA + kstep, voffA); PG8_STAGE(PG8_SB(1, 1), cB + hstepB + kstepB, voffB);
        PG8_WAIT_V(6); PG8_BAR;
    }
    for (;;) {
        const bool has_next = S.next(ui + 1, nxt);
        const char* nA = has_next ? S.aptr(nxt) : cA; const char* nB = has_next ? S.bptr(nxt) : cB;
        for (int t = 0; t < nt; t += 2) {
            const bool last = (t == nt - 2);
            const char* a1 = cA + (size_t)(t + 1) * kstep;
            const char* a2 = last ? nA : cA + (size_t)(t + 2) * kstep; const char* b2 = last ? nB : cB + (size_t)(t + 2) * kstepB;
            const char* a3 = a2 + kstep; const char* b3 = b2 + kstepB;
            if constexpr (SP2) {
            PG8_LDB(B0, 0, 0); PG8_LDB(B1, 0, 1); PG8_SCHED; PG8_LDA(At, 0, 0); PG8_STAGE(PG8_SA(1, 1), a1 + hstepA, voffA);
            PG8_WAIT_V(8); PG8_WAIT_L(0); PG8_BAR; PG8_MMA(0, 0, At, B0); PG8_MMA(0, 1, At, B1); PG8_BAR; PG8_SCHED;
            PG8_LDA(At, 0, 1); PG8_STAGE(PG8_SB(0, 0), b2, voffB); PG8_STAGE(PG8_SB(0, 1), b2 + hstepB, voffB); PG8_STAGE(PG8_SA(0, 0), a2, voffA);
            PG8_WAIT_V(8); PG8_WAIT_L(0); PG8_BAR; PG8_MMA(1, 0, At, B0); PG8_MMA(1, 1, At, B1); PG8_BAR; PG8_SCHED;
            PG8_LDB(B0, 1, 0); PG8_LDB(B1, 1, 1); PG8_SCHED; PG8_LDA(At, 1, 0); PG8_STAGE(PG8_SA(0, 1), a2 + hstepA, voffA);
            PG8_WAIT_V(8); PG8_WAIT_L(0); PG8_BAR; PG8_MMA(0, 0, At, B0); PG8_MMA(0, 1, At, B1); PG8_BAR; PG8_SCHED;
            PG8_LDA(At, 1, 1); PG8_STAGE(PG8_SB(1, 0), b3, voffB); PG8_STAGE(PG8_SB(1, 1), b3 + hstepB, voffB); PG8_STAGE(PG8_SA(1, 0), a3, voffA);
            PG8_WAIT_V(8); PG8_WAIT_L(0); PG8_BAR; PG8_MMA(1, 0, At, B0); PG8_MMA(1, 1, At, B1); PG8_BAR; PG8_SCHED;
            } else {
            PG8_LDB(B0, 0, 0); PG8_SCHED; PG8_LDA(At, 0, 0); PG8_STAGE(PG8_SA(1, 1), a1 + hstepA, voffA);
            PG8_WAIT_L(8); PG8_BAR; PG8_WAIT_L(0); PG8_MMA(0, 0, At, B0); PG8_BAR; PG8_SCHED;
            PG8_LDB(B1, 0, 1); PG8_STAGE(PG8_SB(0, 0), b2, voffB);
            PG8_BAR; PG8_WAIT_L(0); PG8_MMA(0, 1, At, B1); PG8_BAR;
            PG8_LDA(At, 0, 1); PG8_STAGE(PG8_SA(0, 0), a2, voffA);
            PG8_BAR; PG8_WAIT_L(0); PG8_MMA(1, 0, At, B0); PG8_BAR; PG8_SCHED;
            PG8_STAGE(PG8_SB(0, 1), b2 + hstepB, voffB);
            PG8_WAIT_V(6); PG8_BAR; PG8_MMA(1, 1, At, B1); PG8_BAR;
            PG8_LDB(B0, 1, 0); PG8_SCHED; PG8_LDA(At, 1, 0); PG8_STAGE(PG8_SA(0, 1), a2 + hstepA, voffA);
            PG8_WAIT_L(8); PG8_BAR; PG8_WAIT_L(0); PG8_MMA(0, 0, At, B0); PG8_BAR; PG8_SCHED;
            PG8_LDB(B1, 1, 1); PG8_STAGE(PG8_SB(1, 0), b3, voffB);
            PG8_BAR; PG8_WAIT_L(0); PG8_MMA(0, 1, At, B1); PG8_BAR;
            PG8_LDA(At, 1, 1); PG8_STAGE(PG8_SA(1, 0), a3, voffA);
            PG8_BAR; PG8_WAIT_L(0); PG8_MMA(1, 0, At, B0); PG8_BAR; PG8_SCHED;
            PG8_STAGE(PG8_SB(1, 1), b3 + hstepB, voffB);
            PG8_WAIT_V(6); PG8_BAR; PG8_MMA(1, 1, At, B1); PG8_BAR;
            }
        }
        if constexpr (ALIGN_EPI) { if (wr == 0) PG8_BAR; }
        { unsigned on_ = ~0u; asm volatile("" : "+s"(on_)); const int ln_ = (int)__builtin_amdgcn_mbcnt_hi(on_, __builtin_amdgcn_mbcnt_lo(on_, 0u)); int fr_ = ln_ & 15, fq_ = ln_ >> 4; asm volatile("" : "+v"(fr_), "+v"(fq_));
          E(acc, cur, wr, wc, fr_, fq_, pre); }
        if (!has_next) break;
#pragma unroll
        for (int a = 0; a < 2; ++a)
#pragma unroll
            for (int b = 0; b < 2; ++b)
#pragma unroll
                for (int m = 0; m < 4; ++m)
#pragma unroll
                    for (int n = 0; n < 2; ++n) acc[a][b][m][n] = (f32x4){0.f, 0.f, 0.f, 0.f};
        cur = nxt; cA = nA; cB = nB; ++ui;
        E.prefetch(pre, cur, wr, fr);
        if constexpr (ALIGN_EPI) { if (wr == 1) PG8_BAR; }
    }
    PG8_WAIT_V(0);
    if constexpr (!ALIGN_EPI) { if (wr == 0) PG8_BAR; }
    PG8_BAR;
    E.finish(pre, wid, lane);
#undef PG8_SA
#undef PG8_SB
#undef PG8_STAGE
#undef PG8_LDA
#undef PG8_LDB
#undef PG8_MMA
#undef PG8_WAIT_V
#undef PG8_WAIT_L
#undef PG8_BAR
#undef PG8_SCHED
}

template <bool ATILED_> struct ProbDense {
    static constexpr bool BTILED = true, ATILED = ATILED_;
    const bf16_t* A; const bf16_t* Bt; int K, lda, ldb; size_t bbatch; Order2D ord; bool asliced;
    __device__ __forceinline__ bool next(int i, Unit& u) const { u.z = 0; return ord.next(i, u.pm, u.pn); }
    __device__ __forceinline__ const char* aptr(const Unit& u) const { return (const char*)(A + (asliced ? xrow(u.pm * BM, lda) : (size_t)u.pm * BM * lda)); }
    __device__ __forceinline__ const char* bptr(const Unit& u) const { return (const char*)(Bt + (size_t)(u.pm >> 3) * bbatch + (size_t)u.pn * BM * ldb); }
};
struct ProbKV {
    static constexpr bool BTILED = true, ATILED = false;
    const bf16_t* A; const bf16_t* Bt0; size_t lstride; int K, lda, ldb; int G, c;
    __device__ __forceinline__ bool next(int i, Unit& u) const { const int L = i * G + c; if (L >= 256) return false; const int g = L & 7, k = L >> 3; u.z = 0; u.pm = 2 * g + (k >> 4); u.pn = k & 15; return true; }
    __device__ __forceinline__ const char* aptr(const Unit& u) const { return (const char*)(A + (size_t)u.pm * BM * lda); }
    __device__ __forceinline__ const char* bptr(const Unit& u) const { return (const char*)(Bt0 + (size_t)(u.pn >> 3) * lstride + (size_t)(u.pn & 7) * BM * ldb); }
};
struct ProbAbsorb {
    static constexpr bool BTILED = false, ATILED = false;
    const bf16_t* A; const bf16_t* Bt; int K, lda, ldb; size_t a_b, a_h, a_q, b_b, b_h, b_q; int G, c;
    __device__ __forceinline__ bool next(int i, Unit& u) const { const int L = i * G + c; if (L >= 256) return false; u.pn = L & 3; u.pm = (L >> 2) & 3; u.z = L >> 4; return true; }
    __device__ __forceinline__ const char* aptr(const Unit& u) const { return (const char*)(A + (size_t)u.z * a_b + (size_t)u.pm * a_h + (size_t)u.pn * a_q); }
    __device__ __forceinline__ const char* bptr(const Unit& u) const { return (const char*)(Bt + (size_t)u.z * b_b + (size_t)u.pm * b_h + (size_t)u.pn * b_q); }
};

__device__ __forceinline__ u32x4 pack8(const f32x4 v0, const f32x4 v1) { u32x4 w; w.x = cvt_pk_bf16(v0[0], v0[1]); w.y = cvt_pk_bf16(v0[2], v0[3]); w.z = cvt_pk_bf16(v1[0], v1[1]); w.w = cvt_pk_bf16(v1[2], v1[3]); return w; }

__device__ __forceinline__ float xor16(float x, bool odd_row) { const unsigned u = __float_as_uint(x); auto r = __builtin_amdgcn_permlane16_swap(u, u, false, false); return __uint_as_float(odd_row ? r[0] : r[1]); }
__device__ __forceinline__ float quad_sum(float x) {
    { const unsigned u = __float_as_uint(x); auto r = __builtin_amdgcn_permlane16_swap(u, u, false, false); x = __uint_as_float(r[0]) + __uint_as_float(r[1]); }
    { const unsigned u = __float_as_uint(x); auto r = __builtin_amdgcn_permlane32_swap(u, u, false, false); x = __uint_as_float(r[0]) + __uint_as_float(r[1]); }
    return x;
}
__device__ __forceinline__ float quad_max(float x) {
    { const unsigned u = __float_as_uint(x); auto r = __builtin_amdgcn_permlane16_swap(u, u, false, false); x = fmaxf(__uint_as_float(r[0]), __uint_as_float(r[1])); }
    { const unsigned u = __float_as_uint(x); auto r = __builtin_amdgcn_permlane32_swap(u, u, false, false); x = fmaxf(__uint_as_float(r[0]), __uint_as_float(r[1])); }
    return x;
}
struct PreNone {};
struct EpiKV {
    bf16_t* O; size_t lstride;
    typedef PreNone Pre; __device__ __forceinline__ void init(Pre&) const {} __device__ __forceinline__ void finish(Pre&, int, int) const {} __device__ __forceinline__ void prefetch(Pre&, const Unit&, int, int) const {}
    __device__ __forceinline__ void operator()(f32x4 (&acc)[2][2][4][2], const Unit& u, int wr, int wc, int fr, int fq, const Pre&) const {
        bf16_t* base = O + (size_t)(u.pn >> 3) * lstride + (size_t)(u.pm * BM + wr * 64 + fr) * 2048 + (u.pn & 7) * BM + wc * 32 + 8 * fq;
#pragma unroll
        for (int ai = 0; ai < 2; ++ai)
#pragma unroll
            for (int m = 0; m < 4; ++m) { bf16_t* rowp = base + (size_t)(ai * HALF + m * 16) * 2048;
#pragma unroll
                for (int bj = 0; bj < 2; ++bj) *(u32x4*)(rowp + bj * HALF) = pack8(acc[ai][bj][m][0], acc[ai][bj][m][1]); }
    }
};
struct EpiAbsorb {
    bf16_t* O; bool rows_by_h;
    typedef PreNone Pre; __device__ __forceinline__ void init(Pre&) const {} __device__ __forceinline__ void finish(Pre&, int, int) const {} __device__ __forceinline__ void prefetch(Pre&, const Unit&, int, int) const {}
    __device__ __forceinline__ void operator()(f32x4 (&acc)[2][2][4][2], const Unit& u, int wr, int wc, int fr, int fq, const Pre&) const {
        bf16_t* base = O + (size_t)u.z * ((size_t)1024 * 1024);
        const int n0 = (rows_by_h ? u.pm : u.pn) * 256 + wr * 64 + fr, k0 = (rows_by_h ? u.pn : u.pm) * 256 + wc * 32 + 8 * fq;
#pragma unroll
        for (int ai = 0; ai < 2; ++ai)
#pragma unroll
            for (int m = 0; m < 4; ++m)
#pragma unroll
                for (int bj = 0; bj < 2; ++bj) *(u32x4*)(base + btile_off(n0 + ai * HALF + m * 16, k0 + bj * HALF, 1024)) = pack8(acc[ai][bj][m][0], acc[ai][bj][m][1]);
    }
};
typedef unsigned long long rss_t;
constexpr float RSS_SCALE = 1048576.0f, RSS_INV = 1.0f / 1048576.0f;
__device__ __forceinline__ float rss_val(const rss_t* rowss, int row) { const rss_t v = rowss[row]; return ((float)(unsigned)(v >> 32) * 4096.0f + (float)(unsigned)v * RSS_INV); }
__device__ __forceinline__ rss_t rss_fix(float ss) { return (rss_t)(ss * RSS_SCALE + 0.5f); }
__device__ __forceinline__ float rstd_of(const rss_t* rowss, int row) { return __builtin_amdgcn_rsqf(rss_val(rowss, row) * (1.0f / 1024.0f) + NORM_EPS); }

struct PreRss { rss_t v[2][4]; };
__device__ __forceinline__ void rss_prefetch(PreRss& p, const rss_t* rowss, int row0) {
#pragma unroll
    for (int ai = 0; ai < 2; ++ai)
#pragma unroll
        for (int m = 0; m < 4; ++m) p.v[ai][m] = rowss[row0 + ai * HALF + m * 16];
}
__device__ __forceinline__ void rstd8(float (&r)[2][4], const PreRss& p, float sc) {
    const rss_t (&v)[2][4] = p.v;
#pragma unroll
    for (int ai = 0; ai < 2; ++ai)
#pragma unroll
        for (int m = 0; m < 4; ++m) r[ai][m] = __builtin_amdgcn_rsqf(((float)(unsigned)(v[ai][m] >> 32) * 4096.0f + (float)(unsigned)v[ai][m] * RSS_INV) * (1.0f / 1024.0f) + NORM_EPS) * sc;
}
struct EpiIn {
    bf16_t *Q, *Kb, *V, *Bg, *U; const rss_t* rowss; const float* cs;
    typedef PreRss Pre; __device__ __forceinline__ void init(Pre&) const {} __device__ __forceinline__ void finish(Pre&, int, int) const {} __device__ __forceinline__ void prefetch(Pre& p, const Unit& u, int wr, int fr) const { rss_prefetch(p, rowss, u.pm * BM + wr * 64 + fr); }
    __device__ __forceinline__ void operator()(f32x4 (&acc)[2][2][4][2], const Unit& u, int wr, int wc, int fr, int fq, const Pre& pre) const {
        const int pn = u.pn; const int row0 = u.pm * BM + wr * 64 + fr, colw = wc * 32 + 8 * fq;
        float r[2][4];
        if (pn < 4) {
            bf16_t* dst = (pn < 2 ? Q : Kb) + xrow(row0, 512) + (pn & 1) * 256 + colw;
            rstd8(r, pre, pn < 2 ? C2_ATT : 1.0f);
            const bool rotw = (wc & 1) == 0; const float sgn = fq == 0 ? -1.0f : 1.0f; const bool rotl = fq < 2;
            if (rotw) {
                const f32x4* cp = (const f32x4*)(cs + (size_t)row0 * 16); f32x4 nc0 = cp[0], nc1 = cp[1], ns0 = cp[2], ns1 = cp[3];
#pragma unroll
                for (int i = 0; i < 8; ++i) { const int ai = i >> 2, m = i & 3; const f32x4 c0 = nc0, c1 = nc1, s0 = ns0, s1 = ns1;
                    if (i < 7) { const int i2 = i + 1; const f32x4* cq = (const f32x4*)(cs + (size_t)(row0 + (i2 >> 2) * HALF + (i2 & 3) * 16) * 16); nc0 = cq[0]; nc1 = cq[1]; ns0 = cq[2]; ns1 = cq[3]; }
#pragma unroll
                    for (int bj = 0; bj < 2; ++bj) { f32x4 v0 = acc[ai][bj][m][0] * r[ai][m], v1 = acc[ai][bj][m][1] * r[ai][m], o0, o1;
#pragma unroll
                        for (int j = 0; j < 4; ++j) { o0[j] = xor16(v0[j], (fq & 1) != 0); o1[j] = xor16(v1[j], (fq & 1) != 0); }
                        if (rotl) { v0 = v0 * c0 + o0 * s0 * sgn; v1 = v1 * c1 + o1 * s1 * sgn; }
                        *(u32x4*)(dst + (size_t)(ai * HALF + m * 16) * 512 + bj * HALF) = pack8(v0, v1); }
                    asm volatile("" ::: "memory"); }
            } else {
#pragma unroll
                for (int ai = 0; ai < 2; ++ai)
#pragma unroll
                    for (int m = 0; m < 4; ++m)
#pragma unroll
                        for (int bj = 0; bj < 2; ++bj) *(u32x4*)(dst + (size_t)(ai * HALF + m * 16) * 512 + bj * HALF) = pack8(acc[ai][bj][m][0] * r[ai][m], acc[ai][bj][m][1] * r[ai][m]);
            }
        } else if (pn < 8) {
            bf16_t* dst = (pn < 6 ? V : Bg) + xrow(row0, 512) + (pn & 1) * 256 + colw;
            rstd8(r, pre, 1.0f);
#pragma unroll
            for (int ai = 0; ai < 2; ++ai)
#pragma unroll
                for (int m = 0; m < 4; ++m)
#pragma unroll
                    for (int bj = 0; bj < 2; ++bj) *(u32x4*)(dst + (size_t)(ai * HALF + m * 16) * 512 + bj * HALF) = pack8(acc[ai][bj][m][0] * r[ai][m], acc[ai][bj][m][1] * r[ai][m]);
        } else {
            bf16_t* dst = U + xrow(row0, 512) + (pn - 8) * 128 + colw;
            rstd8(r, pre, 1.0f);
#pragma unroll
            for (int ai = 0; ai < 2; ++ai)
#pragma unroll
                for (int m = 0; m < 4; ++m) { const float r2 = r[ai][m] * r[ai][m];
                    *(u32x4*)(dst + (size_t)(ai * HALF + m * 16) * 512) = pack8(acc[ai][0][m][0] * acc[ai][1][m][0] * r2, acc[ai][0][m][1] * acc[ai][1][m][1] * r2); }
        }
    }
};
struct EpiRes {
    float* H32; bf16_t* HB; rss_t* rowss_out; float scale; bool do_ss; PG8_LAS float* X;
    struct Pre { int prev_pm, buf; };
    __device__ __forceinline__ void init(Pre& p) const { p.prev_pm = -1; p.buf = 0; }
    __device__ __forceinline__ void prefetch(Pre&, const Unit&, int, int) const {}
    __device__ __forceinline__ void flush(int pm, int bufsel, int wv, int ln) const {
        if (ln < 32 && do_ss) { const int rl = wv * 32 + ln; const f32x4 p4 = *(const PG8_LAS f32x4*)(X + bufsel * 1024 + rl * 4);
            atomicAdd(rowss_out + pm * BM + rl, rss_fix((p4[0] + p4[1]) + (p4[2] + p4[3]))); } }
    __device__ __forceinline__ void finish(Pre& p, int wv, int ln) const { if (p.prev_pm >= 0) flush(p.prev_pm, p.buf ^ 1, wv, ln); }
    __device__ __forceinline__ void operator()(f32x4 (&acc)[2][2][4][2], const Unit& u, int wr, int wc, int fr, int fq, Pre& pst) const {
        const int row0 = u.pm * BM + wr * 64 + fr, col0 = u.pn * BM + wc * 32 + 8 * fq;
#if RES_F32
#pragma unroll
        for (int ai = 0; ai < 2; ++ai)
#pragma unroll
            for (int m = 0; m < 4; ++m) { const int row = row0 + ai * HALF + m * 16; float ss = 0.f;
#pragma unroll
                for (int bj = 0; bj < 2; ++bj) { const size_t off = (size_t)row * 1024 + col0 + bj * HALF; f32x4 v0, v1;
                    v0 = *(const f32x4*)(H32 + off); v1 = *(const f32x4*)(H32 + off + 4);
                    v0 = v0 + acc[ai][bj][m][0] * scale; v1 = v1 + acc[ai][bj][m][1] * scale;
                    *(f32x4*)(H32 + off) = v0; *(f32x4*)(H32 + off + 4) = v1;
                    *(u32x4*)(HB + off) = pack8(v0, v1);
                    ss += (v0[0] * v0[0] + v0[1] * v0[1]) + (v0[2] * v0[2] + v0[3] * v0[3]) + (v1[0] * v1[0] + v1[1] * v1[1]) + (v1[2] * v1[2] + v1[3] * v1[3]); }
                ss = quad_sum(ss);
                if (fq == 0 && do_ss) atomicAdd(rowss_out + row, rss_fix(ss));
                if (m & 1) asm volatile("" ::: "memory"); }
#else
        TileAddr ta; ta.init(HB + (size_t)__builtin_amdgcn_readfirstlane(u.pm) * (BM * 1024), u.pn, wr, wc, fr, fq);
#define HBP(ai_, bj_, m_) ta.at(ai_, bj_, m_)
        u32x4 old[8][2];
#pragma unroll
        for (int i = 0; i < 8; ++i) { old[i][0] = *HBP(i >> 2, 0, i & 3); old[i][1] = *HBP(i >> 2, 1, i & 3); }
#pragma unroll
        for (int i = 0; i < 8; ++i) { const int ai = i >> 2, m = i & 3;
            f32x2 s2 = (f32x2){0.f, 0.f};
#pragma unroll
            for (int bj = 0; bj < 2; ++bj) { const u32x4 hw = old[i][bj];
                f32x4 v0 = (f32x4){__uint_as_float(hw.x << 16), __uint_as_float(hw.x & 0xffff0000u), __uint_as_float(hw.y << 16), __uint_as_float(hw.y & 0xffff0000u)};
                f32x4 v1 = (f32x4){__uint_as_float(hw.z << 16), __uint_as_float(hw.z & 0xffff0000u), __uint_as_float(hw.w << 16), __uint_as_float(hw.w & 0xffff0000u)};
                v0 = v0 + acc[ai][bj][m][0] * scale; v1 = v1 + acc[ai][bj][m][1] * scale;
                *HBP(ai, bj, m) = pack8(v0, v1);
                const f32x2 p0 = (f32x2){v0[0], v0[1]}, p1 = (f32x2){v0[2], v0[3]}, p2 = (f32x2){v1[0], v1[1]}, p3 = (f32x2){v1[2], v1[3]};
                s2 = s2 + p0 * p0; s2 = s2 + p1 * p1; s2 = s2 + p2 * p2; s2 = s2 + p3 * p3; }
            float ss = s2[0] + s2[1];
            ss = quad_sum(ss);
            if (fq == 0) X[pst.buf * 1024 + (ai * HALF + wr * 64 + m * 16 + fr) * 4 + wc] = ss; }
        { const int wv = wr * 4 + wc; int ln = fq * 16 + fr; asm volatile("" : "+v"(ln));
          if (pst.prev_pm >= 0) flush(pst.prev_pm, pst.buf ^ 1, wv, ln);
          pst.prev_pm = u.pm; pst.buf ^= 1; }
        asm volatile("s_waitcnt lgkmcnt(0)" ::: "memory");
#undef HBP
#endif
    }
};
struct EpiSoftmax {
    bf16_t* P; const rss_t* rowss; PG8_LAS f32x2* X;
    typedef PreRss Pre; __device__ __forceinline__ void init(Pre&) const {} __device__ __forceinline__ void finish(Pre&, int, int) const {} __device__ __forceinline__ void prefetch(Pre& p, const Unit& u, int wr, int fr) const { rss_prefetch(p, rowss, u.pm * BM + wr * 64 + fr); }
    __device__ __forceinline__ void operator()(f32x4 (&acc)[2][2][4][2], const Unit& u, int wr, int wc, int fr, int fq, const Pre& pre) const {
        const int row0 = u.pm * BM + wr * 64 + fr, col0 = u.pn * BM + wc * 32 + 8 * fq;
        float mown[2][4], rr[2][4]; rstd8(rr, pre, C2_X);
#pragma unroll
        for (int ai = 0; ai < 2; ++ai)
#pragma unroll
            for (int m = 0; m < 4; ++m) { const float r = rr[ai][m]; float mx = -INFINITY;
#pragma unroll
                for (int bj = 0; bj < 2; ++bj)
#pragma unroll
                    for (int n = 0; n < 2; ++n) { f32x4 s = acc[ai][bj][m][n] * r; acc[ai][bj][m][n] = s; mx = fmaxf(mx, fmaxf(fmaxf(s[0], s[1]), fmaxf(s[2], s[3]))); }
                mx = quad_max(mx); float l = 0.f;
#pragma unroll
                for (int bj = 0; bj < 2; ++bj)
#pragma unroll
                    for (int n = 0; n < 2; ++n) { f32x4 s = acc[ai][bj][m][n]; f32x4 e;
#pragma unroll
                        for (int j = 0; j < 4; ++j) e[j] = __builtin_amdgcn_exp2f(s[j] - mx);
                        acc[ai][bj][m][n] = e; l += (e[0] + e[1]) + (e[2] + e[3]); }
                l = quad_sum(l);
                mown[ai][m] = mx;
                if (fq == 0) X[(ai * HALF + wr * 64 + m * 16 + fr) * 4 + wc] = (f32x2){mx, l}; }
        asm volatile("s_waitcnt lgkmcnt(0)" ::: "memory"); __builtin_amdgcn_s_barrier(); asm volatile("" ::: "memory");
        TileAddr ta; ta.init(P + xrow(__builtin_amdgcn_readfirstlane(u.pm) * BM, 1024), u.pn, wr, wc, fr, fq);
#pragma unroll
        for (int ai = 0; ai < 2; ++ai)
#pragma unroll
            for (int m = 0; m < 4; ++m) { const int rl = ai * HALF + wr * 64 + m * 16 + fr;
                const f32x2 a = X[rl * 4 + 0], b = X[rl * 4 + 1], c = X[rl * 4 + 2], d = X[rl * 4 + 3];
                const float M = fmaxf(fmaxf(a.x, b.x), fmaxf(c.x, d.x));
                const float L = (a.y * __builtin_amdgcn_exp2f(a.x - M) + b.y * __builtin_amdgcn_exp2f(b.x - M)) + (c.y * __builtin_amdgcn_exp2f(c.x - M) + d.y * __builtin_amdgcn_exp2f(d.x - M));
                const float f = __builtin_amdgcn_exp2f(mown[ai][m] - M) / L;
#pragma unroll
                for (int bj = 0; bj < 2; ++bj) *ta.at(ai, bj, m) = pack8(acc[ai][bj][m][0] * f, acc[ai][bj][m][1] * f); }
    }
};
struct EpiRelu2 {
    bf16_t* F; const rss_t* rowss;
    typedef PreRss Pre; __device__ __forceinline__ void init(Pre&) const {} __device__ __forceinline__ void finish(Pre&, int, int) const {} __device__ __forceinline__ void prefetch(Pre& p, const Unit& u, int wr, int fr) const { rss_prefetch(p, rowss, u.pm * BM + wr * 64 + fr); }
    __device__ __forceinline__ void operator()(f32x4 (&acc)[2][2][4][2], const Unit& u, int wr, int wc, int fr, int fq, const Pre& pre) const {
        const int row0 = u.pm * BM + wr * 64 + fr, col0 = u.pn * BM + wc * 32 + 8 * fq;
        float rr[2][4]; rstd8(rr, pre, 1.0f);
        TileAddr ta; ta.init(F + xrow(__builtin_amdgcn_readfirstlane(u.pm) * BM, FF), u.pn, wr, wc, fr, fq);
#pragma unroll
        for (int ai = 0; ai < 2; ++ai)
#pragma unroll
            for (int m = 0; m < 4; ++m) { const float r = rr[ai][m];
#pragma unroll
                for (int bj = 0; bj < 2; ++bj) { f32x4 v0 = acc[ai][bj][m][0] * r, v1 = acc[ai][bj][m][1] * r;
                    f32x2 q0 = (f32x2){fmaxf(v0[0], 0.f), fmaxf(v0[1], 0.f)}, q1 = (f32x2){fmaxf(v0[2], 0.f), fmaxf(v0[3], 0.f)}, q2 = (f32x2){fmaxf(v1[0], 0.f), fmaxf(v1[1], 0.f)}, q3 = (f32x2){fmaxf(v1[2], 0.f), fmaxf(v1[3], 0.f)};
                    q0 = q0 * q0; q1 = q1 * q1; q2 = q2 * q2; q3 = q3 * q3;
                    u32x4 w; w.x = cvt_pk_bf16(q0[0], q0[1]); w.y = cvt_pk_bf16(q1[0], q1[1]); w.z = cvt_pk_bf16(q2[0], q2[1]); w.w = cvt_pk_bf16(q3[0], q3[1]);
                    *ta.at(ai, bj, m) = w; } }
    }
};
}

namespace attn_body {
using bf16=__hip_bfloat16;
using bf16x8=__attribute__((ext_vector_type(8)))short;
using s16x4=__attribute__((ext_vector_type(4)))short;
using f32x16=__attribute__((ext_vector_type(16)))float;
using u32x4=__attribute__((ext_vector_type(4)))unsigned;
constexpr int SEQL=2048,D=64,PQ=512,PO=1024;
constexpr int NW=8,QBLK=32,QB=QBLK*NW,KVBLK=64,NQB=SEQL/QB;
__device__ __forceinline__ int crow(int r,int hi){return (r&3)+8*(r>>2)+4*hi;}
#define SBAR() __builtin_amdgcn_sched_barrier(0)
__device__ __forceinline__ void cmask(f32x16&p0,f32x16&p1,int jb,int qrel,int hi){
  const float NEG=-INFINITY; int kb=64*jb+4*hi;
  #pragma unroll
  for(int r=0;r<16;++r){int kv=kb+(r&3)+8*(r>>2); if(kv>qrel)p0[r]=NEG; if(kv+32>qrel)p1[r]=NEG;}
}
constexpr int NSLOT=3, SLOTB=8192;
constexpr int LDS_K=0, LDS_V=NSLOT*SLOTB, LDS_WS=2*NSLOT*SLOTB, LDS_OST=LDS_WS+NW*64*4, LDS_BYTES=LDS_OST+NW*4096;
__device__ __forceinline__ void glds16(const void*gsrc,unsigned lds_dst){unsigned keep;
  asm volatile("s_mov_b32 %0, m0\n\ts_mov_b32 m0, %2\n\ts_nop 0\n\tglobal_load_lds_dwordx4 %1, off\n\ts_mov_b32 m0, %0":"=&s"(keep):"v"(gsrc),"s"(lds_dst):"memory");}
__device__ __forceinline__ float max3f(float a,float b,float c){float r;asm("v_max3_f32 %0, %1, %2, %3":"=v"(r):"v"(a),"v"(b),"v"(c));return r;}
__device__ __forceinline__ float max2f(float a,float b){float r;asm("v_max_f32_e32 %0, %1, %2":"=v"(r):"v"(a),"v"(b));return r;}
__device__ __forceinline__ float fadd_s(float a,float b){float r;asm("v_add_f32_e32 %0, %1, %2":"=v"(r):"v"(a),"v"(b));return r;}
__device__ __forceinline__ float fsub_s(float a,float b){float r;asm("v_sub_f32_e32 %0, %1, %2":"=v"(r):"v"(a),"v"(b));return r;}
typedef float f32x2_t __attribute__((ext_vector_type(2))); typedef __bf16 bf16x2_t __attribute__((ext_vector_type(2)));
__device__ __forceinline__ unsigned cvtpk_s(float lo,float hi){f32x2_t v={lo,hi};bf16x2_t b=__builtin_convertvector(v,bf16x2_t);return __builtin_bit_cast(unsigned,b);}
#define WAIT_BAR(N) asm volatile("s_waitcnt vmcnt(" #N ") lgkmcnt(0)\n\ts_barrier":::"memory")

__device__ __forceinline__ void qkt(f32x16&p0,f32x16&p1,const char*Kslot,const bf16x8*qr,const f32x16&negm,int r32,int hi){
  const char*kb=Kslot+hi*1024+r32*16;
  #pragma unroll
  for(int d0=0;d0<4;++d0){
    const bf16x8 b0=*reinterpret_cast<const bf16x8*>(kb+d0*2048);
    const bf16x8 b1=*reinterpret_cast<const bf16x8*>(kb+d0*2048+512);
    if(d0==0){p0=__builtin_amdgcn_mfma_f32_32x32x16_bf16(b0,qr[0],negm,0,0,0);p1=__builtin_amdgcn_mfma_f32_32x32x16_bf16(b1,qr[0],negm,0,0,0);}
    else{p0=__builtin_amdgcn_mfma_f32_32x32x16_bf16(b0,qr[d0],p0,0,0,0);p1=__builtin_amdgcn_mfma_f32_32x32x16_bf16(b1,qr[d0],p1,0,0,0);}}
}
typedef __attribute__((address_space(3))) const char* lds_cptr;
typedef short v4i16_t __attribute__((ext_vector_type(4)));
__device__ __forceinline__ void kload8(bf16x8*kf,lds_cptr kp){
  kf[0]=*(const __attribute__((address_space(3))) bf16x8*)(kp);      kf[1]=*(const __attribute__((address_space(3))) bf16x8*)(kp+512);
  kf[2]=*(const __attribute__((address_space(3))) bf16x8*)(kp+2048); kf[3]=*(const __attribute__((address_space(3))) bf16x8*)(kp+2560);
  kf[4]=*(const __attribute__((address_space(3))) bf16x8*)(kp+4096); kf[5]=*(const __attribute__((address_space(3))) bf16x8*)(kp+4608);
  kf[6]=*(const __attribute__((address_space(3))) bf16x8*)(kp+6144); kf[7]=*(const __attribute__((address_space(3))) bf16x8*)(kp+6656);
}
__device__ __forceinline__ void kload2(bf16x8*kf,lds_cptr kp,int j){ kf[2*j]=*(const __attribute__((address_space(3))) bf16x8*)(kp+j*2048); kf[2*j+1]=*(const __attribute__((address_space(3))) bf16x8*)(kp+j*2048+512); }
__device__ __forceinline__ s16x4 vtr(lds_cptr p){ return __builtin_bit_cast(s16x4,__builtin_amdgcn_ds_read_tr16_b64_v4i16((__attribute__((address_space(3))) v4i16_t*)p)); }
__device__ __forceinline__ float rowmax(const f32x16&p0,const f32x16&p1){
  float a=max3f(p0[0],p0[1],p1[0]),b=max3f(p0[2],p0[3],p1[1]);a=max3f(a,p1[2],p1[3]);
  #pragma unroll
  for(int r=4;r<16;r+=4){a=max3f(a,p0[r],p0[r+1]);b=max3f(b,p0[r+2],p0[r+3]);a=max3f(a,p1[r],p1[r+1]);b=max3f(b,p1[r+2],p1[r+3]);}
  const float m=max2f(a,b);
  auto rr=__builtin_amdgcn_permlane32_swap(__float_as_uint(m),__float_as_uint(m),false,false);
  return max2f(__uint_as_float(rr[0]),__uint_as_float(rr[1]));
}
__device__ __forceinline__ void pv(f32x16*o,int vb,bf16x8 pa0,bf16x8 pa1,bf16x8 pa2,bf16x8 pa3){
  #pragma unroll
  for(int d0=0;d0<2;++d0){s16x4 lo[4],hi[4];
    #pragma unroll
    for(int ks=0;ks<4;++ks){
      asm volatile("ds_read_b64_tr_b16 %0,%1 offset:%c2":"=&v"(lo[ks]):"v"(vb),"i"(d0*4096+ks*1024):"memory");
      asm volatile("ds_read_b64_tr_b16 %0,%1 offset:%c2":"=&v"(hi[ks]):"v"(vb),"i"(d0*4096+ks*1024+512):"memory");}
    asm volatile("s_waitcnt lgkmcnt(0)":::"memory");SBAR();
    #define PK(k) (bf16x8){lo[k][0],lo[k][1],lo[k][2],lo[k][3],hi[k][0],hi[k][1],hi[k][2],hi[k][3]}
    o[d0]=__builtin_amdgcn_mfma_f32_32x32x16_bf16(pa0,PK(0),o[d0],0,0,0);
    o[d0]=__builtin_amdgcn_mfma_f32_32x32x16_bf16(pa1,PK(1),o[d0],0,0,0);
    o[d0]=__builtin_amdgcn_mfma_f32_32x32x16_bf16(pa2,PK(2),o[d0],0,0,0);
    o[d0]=__builtin_amdgcn_mfma_f32_32x32x16_bf16(pa3,PK(3),o[d0],0,0,0);
    #undef PK
  }
}
#define ATTN_STORE16(p,v) (*(u32x4*)(p)=(v))
template<int THRL> __device__ __forceinline__ void attn_unit(int b,int cqk,int cv,int co,int qb,const bf16*Q,const bf16*__restrict__ K,const bf16*__restrict__ V,bf16*O,char*shm,const int tid_in){
  int tid=tid_in; asm volatile("":"+v"(tid));
  const int lane=tid&63,r32=lane&31,hi=lane>>5; const int wid=__builtin_amdgcn_readfirstlane(tid>>6);
  const long rowbase=(long)b*SEQL; const int q0=qb*QB;
  const bf16*Qw=Q+(rowbase+q0+wid*QBLK)*PQ+cqk;
  const bf16*Kh=K+rowbase*PQ+cqk,*Vh=V+rowbase*PQ+cv;
  const unsigned lds0=(unsigned)(uintptr_t)shm;
  float*wsf=(float*)(shm+LDS_WS)+wid*64;
  const bf16*ksrc=Kh+(long)lane*PQ+wid*8;
  const bf16*vsrc=Vh+(long)(16*(wid&3)+(lane>>2))*PQ+(wid>>2)*32+(lane&3)*8;
  const unsigned kdst=lds0+LDS_K+wid*1024, vdst=lds0+LDS_V+wid*1024;
  #define DMA_K(t,slot) glds16(ksrc+(long)(t)*KVBLK*PQ,(unsigned)__builtin_amdgcn_readfirstlane(kdst+(slot)))
  #define DMA_V(t,slot) glds16(vsrc+(long)(t)*KVBLK*PQ,(unsigned)__builtin_amdgcn_readfirstlane(vdst+(slot)))
  const int vb0=(int)(lds0+LDS_V)+((lane>>4)&1)*32+(lane&3)*8+(4*hi+((lane&15)>>2))*64;
  const char*Kbase=shm+LDS_K; bf16x8 kf[8];
  const lds_cptr shm3=(lds_cptr)shm; const lds_cptr kp0=shm3+LDS_K+hi*1024+r32*16; const lds_cptr vp0=shm3+LDS_V+((lane>>4)&1)*32+(lane&3)*8+(4*hi+((lane&15)>>2))*64;
  const int NT=(q0+QB)/KVBLK;
  DMA_K(0,0);DMA_V(0,0);DMA_K(1,SLOTB);
  bf16x8 qr[4];
  #pragma unroll
  for(int d0=0;d0<4;++d0)qr[d0]=*reinterpret_cast<const bf16x8*>(&Qw[(long)r32*PQ+d0*16+hi*8]);
  float zz_=0.f;asm volatile("":"+v"(zz_));float mhat=zz_,l_reg=zz_;f32x16 o[2];f32x16 negm;
  _Pragma("unroll") for(int r=0;r<16;++r){o[0][r]=zz_;o[1][r]=zz_;negm[r]=zz_;} asm volatile("":"+v"(negm));
  const int qrel=wid*QBLK+r32;
  #define CMASK(P0,P1,t) do{int jb_=(t)-(NT-4); if(jb_>=0)cmask(P0,P1,jb_,qrel,hi);}while(0)
  bool resc=false;
  #define START(P0,P1) do{ const float rm=rowmax(P0,P1); resc=false; \
    { const float dl=rm; mhat=fadd_s(mhat,dl); \
      _Pragma("unroll") for(int r=0;r<16;++r){P0[r]=fsub_s(P0[r],dl);P1[r]=fsub_s(P1[r],dl);} \
      _Pragma("unroll") for(int r=0;r<16;++r)negm[r]=-mhat; asm volatile("":"+v"(negm)); } \
    _Pragma("unroll") for(int r=0;r<16;++r)P0[r]=__builtin_amdgcn_exp2f(P0[r]); }while(0)
  #define RESC() do{ if(resc){ asm volatile("s_waitcnt lgkmcnt(0)":::"memory"); \
      _Pragma("unroll") for(int d_=0;d_<2;++d_) _Pragma("unroll") for(int r=0;r<16;++r)o[d_][r]*=wsf[crow(r,hi)]; } }while(0)
  f32x16 pA0,pA1,pB0,pB1;
  int sl_prev=0,sl_cur=0,sl_next=SLOTB;
  #define ROT() do{sl_prev=sl_cur;sl_cur=sl_next;sl_next=(sl_next==(NSLOT-1)*SLOTB)?0:sl_next+SLOTB;}while(0)
  DMA_K(2,2*SLOTB);
  WAIT_BAR(3);
  qkt(pA0,pA1,Kbase,qr,negm,r32,hi);asm volatile("s_nop 15\n\ts_nop 7":"+v"(pA0),"+v"(pA1));CMASK(pA0,pA1,0);
  START(pA0,pA1);
  _Pragma("unroll") for(int r=0;r<16;++r)pA1[r]=__builtin_amdgcn_exp2f(pA1[r]);
  WAIT_BAR(0);
  DMA_K(3,0);DMA_V(1,SLOTB);
  ROT();
  kload8(kf,kp0+sl_cur);
  WAIT_BAR(2);
  s16x4 vlo[8],vhi[8]; u32x4 pw0,pw1,pw2,pw3;
  #define PKW(P,B) cvtpk_s(P[B],P[B+1])
  #define PAF(k) __builtin_bit_cast(bf16x8,pw##k)
  #define VFR(i) (bf16x8){vlo[i][0],vlo[i][1],vlo[i][2],vlo[i][3],vhi[i][0],vhi[i][1],vhi[i][2],vhi[i][3]}
  #define PIN(x) asm volatile("":"+v"(x))
  #define MX3(a,b,c) __builtin_fmaxf(__builtin_fmaxf((a),(b)),(c))
  #define GAPA(MF,A0,A1,A2,A3,W0,W1,PW) do{ MF; sacc+=A0; sacc+=A1; sacc+=A2; sacc+=A3; PIN(sacc); W0; W1; PIN(PW); SBAR(); }while(0)
  #define EX(v) __builtin_amdgcn_exp2f(v)
  #define GAPB(MF,X,B) do{ MF; X[B]=EX(X[B]); X[B+1]=EX(X[B+1]); X[B+2]=EX(X[B+2]); X[B+3]=EX(X[B+3]); PIN(X); SBAR(); }while(0)
  #define VRD(i) do{ vlo[i]=vtr(vp_+(((i)>>2)*4096+((i)&3)*1024)); vhi[i]=vtr(vp_+(((i)>>2)*4096+((i)&3)*1024+512)); }while(0)
  #define KRD(G,j) do{ if(G){ kload2(kf,kp0+sl_next,j); SBAR(); } }while(0)
  #define STEP(C0,C1,P0,P1,t,GK,GV,GL) do{ SBAR(); \
    const lds_cptr vp_=vp0+sl_prev; \
    VRD(0); SBAR(); float sacc=(P0[0]+P0[1]); \
    GAPA(C0=__builtin_amdgcn_mfma_f32_32x32x16_bf16(kf[0],qr[0],negm,0,0,0), P0[2],P0[3],P0[4],P0[5],     pw0[0]=PKW(P0,0), pw0[1]=PKW(P0,2), pw0); \
    VRD(4); SBAR(); GAPA(C1=__builtin_amdgcn_mfma_f32_32x32x16_bf16(kf[1],qr[0],negm,0,0,0), P0[6],P0[7],P0[8],P0[9],     pw0[2]=PKW(P0,4), pw0[3]=PKW(P0,6), pw0); \
    VRD(1); SBAR(); GAPA(C0=__builtin_amdgcn_mfma_f32_32x32x16_bf16(kf[2],qr[1],C0,0,0,0),   P0[10],P0[11],P0[12],P0[13], pw1[0]=PKW(P0,8), pw1[1]=PKW(P0,10), pw1); \
    VRD(5); SBAR(); GAPA(C1=__builtin_amdgcn_mfma_f32_32x32x16_bf16(kf[3],qr[1],C1,0,0,0),   P0[14],P0[15],P1[0],P1[1],   pw1[2]=PKW(P0,12),pw1[3]=PKW(P0,14), pw1); \
    VRD(2); SBAR(); GAPA(C0=__builtin_amdgcn_mfma_f32_32x32x16_bf16(kf[4],qr[2],C0,0,0,0),   P1[2],P1[3],P1[4],P1[5],     pw2[0]=PKW(P1,0), pw2[1]=PKW(P1,2), pw2); \
    VRD(6); SBAR(); GAPA(C1=__builtin_amdgcn_mfma_f32_32x32x16_bf16(kf[5],qr[2],C1,0,0,0),   P1[6],P1[7],P1[8],P1[9],     pw2[2]=PKW(P1,4), pw2[3]=PKW(P1,6), pw2); \
    VRD(3); SBAR(); GAPA(C0=__builtin_amdgcn_mfma_f32_32x32x16_bf16(kf[6],qr[3],C0,0,0,0),   P1[10],P1[11],P1[12],P1[13], pw3[0]=PKW(P1,8), pw3[1]=PKW(P1,10), pw3); \
    VRD(7); SBAR(); GAPA(C1=__builtin_amdgcn_mfma_f32_32x32x16_bf16(kf[7],qr[3],C1,0,0,0),   P1[14],P1[15],0.f,0.f,       pw3[2]=PKW(P1,12),pw3[3]=PKW(P1,14), pw3); \
    l_reg+=sacc; \
    if(GK){DMA_K((t)+3,sl_cur);} if(GV){DMA_V((t)+1,sl_next);} \
    CMASK(C0,C1,t); \
    { float a=MX3(C0[0],C0[1],C1[0]),b=MX3(C0[2],C0[3],C1[1]); a=MX3(a,C1[2],C1[3]); \
      _Pragma("unroll") for(int r=4;r<16;r+=4){a=MX3(a,C0[r],C0[r+1]);b=MX3(b,C0[r+2],C0[r+3]);a=MX3(a,C1[r],C1[r+1]);b=MX3(b,C1[r+2],C1[r+3]);} \
      float rm=__builtin_fmaxf(a,b); { auto rr=__builtin_amdgcn_permlane32_swap(__float_as_uint(rm),__float_as_uint(rm),false,false); rm=__builtin_fmaxf(__uint_as_float(rr[0]),__uint_as_float(rr[1])); } \
      resc=false; \
      if(__builtin_expect(__any(rm>(float)THRL),0)){ const float dl=__builtin_fmaxf(rm,0.f); mhat+=dl; \
        _Pragma("unroll") for(int r=0;r<16;++r){C0[r]-=dl;C1[r]-=dl;} \
        _Pragma("unroll") for(int r=0;r<16;++r)negm[r]=-mhat; asm volatile("":"+v"(negm)); \
        const float f=__builtin_amdgcn_exp2f(-dl); l_reg*=f; if(hi==0)wsf[r32]=f; resc=true; } } \
    SBAR(); \
    GAPB(o[0]=__builtin_amdgcn_mfma_f32_32x32x16_bf16(PAF(0),VFR(0),o[0],0,0,0), C0,0); \
    GAPB(o[1]=__builtin_amdgcn_mfma_f32_32x32x16_bf16(PAF(0),VFR(4),o[1],0,0,0), C0,4); \
    KRD(GL,0); GAPB(o[0]=__builtin_amdgcn_mfma_f32_32x32x16_bf16(PAF(1),VFR(1),o[0],0,0,0), C0,8); \
    KRD(GL,1); GAPB(o[1]=__builtin_amdgcn_mfma_f32_32x32x16_bf16(PAF(1),VFR(5),o[1],0,0,0), C0,12); \
    KRD(GL,2); GAPB(o[0]=__builtin_amdgcn_mfma_f32_32x32x16_bf16(PAF(2),VFR(2),o[0],0,0,0), C1,0); \
    KRD(GL,3); GAPB(o[1]=__builtin_amdgcn_mfma_f32_32x32x16_bf16(PAF(2),VFR(6),o[1],0,0,0), C1,4); \
    GAPB(o[0]=__builtin_amdgcn_mfma_f32_32x32x16_bf16(PAF(3),VFR(3),o[0],0,0,0), C1,8); \
    GAPB(o[1]=__builtin_amdgcn_mfma_f32_32x32x16_bf16(PAF(3),VFR(7),o[1],0,0,0), C1,12); \
    }while(0)
  int t=1;
  #undef CMASK
  #define CMASK(P0,P1,t) do{}while(0)
  for(;t+5<NT;t+=2){
    STEP(pB0,pB1,pA0,pA1,t,true,true,true);     WAIT_BAR(2); RESC(); ROT();
    STEP(pA0,pA1,pB0,pB1,t+1,true,true,true);   WAIT_BAR(2); RESC(); ROT();
  }
  #undef CMASK
  #define CMASK(P0,P1,t) do{int jb_=(t)-(NT-4); if(jb_>=0)cmask(P0,P1,jb_,qrel,hi);}while(0)
  #define ENDW(tt) do{ if((tt)+3<NT){WAIT_BAR(2);} else if((tt)+2<NT){WAIT_BAR(1);} else {WAIT_BAR(0);} }while(0)
  for(;t+1<NT;t+=2){
    STEP(pB0,pB1,pA0,pA1,t,(t+3<NT),(t+1<NT),(t+1<NT));       ENDW(t);   RESC(); ROT();
    STEP(pA0,pA1,pB0,pB1,t+1,(t+4<NT),(t+2<NT),(t+2<NT));     ENDW(t+1); RESC(); ROT();
  }
  STEP(pB0,pB1,pA0,pA1,NT-1,false,false,false); RESC();
  { float sacc=pB0[0]+pB0[1]; _Pragma("unroll") for(int r=2;r<16;++r)sacc+=pB0[r]; _Pragma("unroll") for(int r=0;r<16;++r)sacc+=pB1[r]; l_reg+=sacc;
    pw0=(u32x4){PKW(pB0,0),PKW(pB0,2),PKW(pB0,4),PKW(pB0,6)};pw1=(u32x4){PKW(pB0,8),PKW(pB0,10),PKW(pB0,12),PKW(pB0,14)};pw2=(u32x4){PKW(pB1,0),PKW(pB1,2),PKW(pB1,4),PKW(pB1,6)};pw3=(u32x4){PKW(pB1,8),PKW(pB1,10),PKW(pB1,12),PKW(pB1,14)};
    SBAR(); pv(o,vb0+sl_cur,PAF(0),PAF(1),PAF(2),PAF(3)); }
  #undef PKW
  #undef PAF
  #undef VFR
  #undef PIN
  #undef MX3
  #undef GAPA
  #undef GAPB
  #undef EX
  #undef VRD
  #undef KRD
  #undef STEP
  #undef ENDW
  {auto rr=__builtin_amdgcn_permlane32_swap(__float_as_uint(l_reg),__float_as_uint(l_reg),false,false);l_reg=__uint_as_float(rr[0])+__uint_as_float(rr[1]);}
  if(hi==0)wsf[32+r32]=l_reg;asm volatile("s_waitcnt lgkmcnt(0)":::"memory");
  float rli[16];
  #pragma unroll
  for(int r=0;r<16;++r)rli[r]=__builtin_amdgcn_rcpf(wsf[32+crow(r,hi)]);
  int lane_e=lane; asm volatile("":"+v"(lane_e));
  bf16*Ow=O+(rowbase+q0+wid*QBLK)*PO+co;
  { bf16*stg=(bf16*)(shm+LDS_OST)+wid*2048;
    #pragma unroll
    for(int r=0;r<16;++r){const int orow=crow(r,hi);
      #pragma unroll
      for(int d0=0;d0<2;++d0)stg[orow*64+d0*32+r32]=__float2bfloat16(o[d0][r]*rli[r]);}
    asm volatile("s_waitcnt lgkmcnt(0)":::"memory");
    #pragma unroll
    for(int i=0;i<4;++i){const int row=i*8+(lane_e>>3),ch=lane_e&7; const u32x4 v=*(const u32x4*)(stg+row*64+ch*8); ATTN_STORE16(Ow+(long)row*PO+ch*8,v);} }
  asm volatile("s_waitcnt lgkmcnt(0)\n\ts_barrier":::"memory");
  #undef DMA_K
  #undef DMA_V
  #undef CMASK
  #undef START
  #undef RESC
  #undef ROT
}

constexpr int VSLOTB=2*SLOTB;
constexpr int L2_K=0, L2_V=NSLOT*SLOTB, L2_WS=L2_V+NSLOT*VSLOTB, L2_OST=L2_WS+NW*64*4, LDS128_BYTES=L2_OST+NW*4096;
__device__ __forceinline__ void pv128(f32x16*o,int vb,bf16x8 pa0,bf16x8 pa1,bf16x8 pa2,bf16x8 pa3){
  #pragma unroll
  for(int d0=0;d0<4;++d0){s16x4 lo[4],hi[4];
    #pragma unroll
    for(int ks=0;ks<4;++ks){
      asm volatile("ds_read_b64_tr_b16 %0,%1 offset:%c2":"=&v"(lo[ks]):"v"(vb),"i"(d0*4096+ks*1024):"memory");
      asm volatile("ds_read_b64_tr_b16 %0,%1 offset:%c2":"=&v"(hi[ks]):"v"(vb),"i"(d0*4096+ks*1024+512):"memory");}
    asm volatile("s_waitcnt lgkmcnt(0)":::"memory");SBAR();
    #define PK(k) (bf16x8){lo[k][0],lo[k][1],lo[k][2],lo[k][3],hi[k][0],hi[k][1],hi[k][2],hi[k][3]}
    o[d0]=__builtin_amdgcn_mfma_f32_32x32x16_bf16(pa0,PK(0),o[d0],0,0,0);
    o[d0]=__builtin_amdgcn_mfma_f32_32x32x16_bf16(pa1,PK(1),o[d0],0,0,0);
    o[d0]=__builtin_amdgcn_mfma_f32_32x32x16_bf16(pa2,PK(2),o[d0],0,0,0);
    o[d0]=__builtin_amdgcn_mfma_f32_32x32x16_bf16(pa3,PK(3),o[d0],0,0,0);
    #undef PK
  }
}
template<int THRL> __device__ __forceinline__ void attn_unit128(int b,int cqk,int cv,int co,int qb,const bf16*Q,const bf16*__restrict__ K,const bf16*__restrict__ V,bf16*O,char*shm,const int tid_in){
  int tid=tid_in; asm volatile("":"+v"(tid));
  const int lane=tid&63,r32=lane&31,hi=lane>>5; const int wid=__builtin_amdgcn_readfirstlane(tid>>6);
  const long gsl=(long)(b>>1)*((long)16<<20); const long rowbase=(long)(b&1)*SEQL; const int q0=qb*QB;
  const long pq0=(((rowbase+q0)>>8)<<20), pb0=((rowbase>>8)<<20);
  const bf16*Qw=Q+gsl+pq0+(long)(wid*QBLK)*PQ+cqk;
  const bf16*Kh=K+gsl+pb0+cqk,*Vh=V+gsl+pb0+cv;
  const unsigned lds0=(unsigned)(uintptr_t)shm;
  float*wsf=(float*)(shm+L2_WS)+wid*64;
  const bf16*ksrc=Kh+(long)lane*PQ+wid*8;
  const bf16*vsrc=Vh+(long)(16*(wid&3)+(lane>>2))*PQ+(wid>>2)*32+(lane&3)*8;
  const unsigned kdst=lds0+L2_K+wid*1024, vdst=lds0+L2_V+wid*1024;
  #define TOFF(t) ((((long)(t)>>2)<<20)+((long)(t)&3)*(KVBLK*PQ))
  #define DMA_K(t,slot) glds16(ksrc+TOFF(t),(unsigned)__builtin_amdgcn_readfirstlane(kdst+(slot)))
  #define DMA_V(t,slot) do{ glds16(vsrc+TOFF(t),(unsigned)__builtin_amdgcn_readfirstlane(vdst+2*(slot))); glds16(vsrc+TOFF(t)+64,(unsigned)__builtin_amdgcn_readfirstlane(vdst+2*(slot)+8192)); }while(0)
  const int vb0=(int)(lds0+L2_V)+((lane>>4)&1)*32+(lane&3)*8+(4*hi+((lane&15)>>2))*64;
  const char*Kbase=shm+L2_K; bf16x8 kf[8];
  const lds_cptr shm3=(lds_cptr)shm; const lds_cptr kp0=shm3+L2_K+hi*1024+r32*16; const lds_cptr vp0=shm3+L2_V+((lane>>4)&1)*32+(lane&3)*8+(4*hi+((lane&15)>>2))*64;
  const int NT=(q0+QB)/KVBLK;
  DMA_K(0,0);DMA_V(0,0);DMA_K(1,SLOTB);
  bf16x8 qr[4];
  #pragma unroll
  for(int d0=0;d0<4;++d0)qr[d0]=*reinterpret_cast<const bf16x8*>(&Qw[(long)r32*PQ+d0*16+hi*8]);
  float zz_=0.f;asm volatile("":"+v"(zz_));float mhat=zz_,l_reg=zz_;f32x16 o[4];
  _Pragma("unroll") for(int r=0;r<16;++r){o[0][r]=zz_;o[1][r]=zz_;o[2][r]=zz_;o[3][r]=zz_;}
  const f32x16 z16=f32x16{};
  const int qrel=wid*QBLK+r32;
  #define CMASK(P0,P1,t) do{int jb_=(t)-(NT-4); if(jb_>=0)cmask(P0,P1,jb_,qrel,hi);}while(0)
  bool resc=false;
  #define RESC() do{ if(resc){ asm volatile("s_waitcnt lgkmcnt(0)":::"memory"); \
      _Pragma("unroll") for(int d_=0;d_<4;++d_) _Pragma("unroll") for(int r=0;r<16;++r)o[d_][r]*=wsf[crow(r,hi)]; } }while(0)
  f32x16 pA0,pA1,pB0,pB1;
  int sl_prev=0,sl_cur=0,sl_next=SLOTB;
  #define ROT() do{sl_prev=sl_cur;sl_cur=sl_next;sl_next=(sl_next==(NSLOT-1)*SLOTB)?0:sl_next+SLOTB;}while(0)
  DMA_K(2,2*SLOTB);
  asm volatile("s_waitcnt vmcnt(3) lgkmcnt(0)\n\ts_barrier":::"memory");
  { const char*kb=Kbase+hi*1024+r32*16;
    #pragma unroll
    for(int d0=0;d0<4;++d0){ const bf16x8 b0=*reinterpret_cast<const bf16x8*>(kb+d0*2048); const bf16x8 b1=*reinterpret_cast<const bf16x8*>(kb+d0*2048+512);
      if(d0==0){pA0=__builtin_amdgcn_mfma_f32_32x32x16_bf16(b0,qr[0],z16,0,0,0);pA1=__builtin_amdgcn_mfma_f32_32x32x16_bf16(b1,qr[0],z16,0,0,0);}
      else{pA0=__builtin_amdgcn_mfma_f32_32x32x16_bf16(b0,qr[d0],pA0,0,0,0);pA1=__builtin_amdgcn_mfma_f32_32x32x16_bf16(b1,qr[d0],pA1,0,0,0);}} }
  asm volatile("s_nop 15\n\ts_nop 7":"+v"(pA0),"+v"(pA1));CMASK(pA0,pA1,0);
  { const float rm=rowmax(pA0,pA1); mhat=fadd_s(mhat,rm);
    _Pragma("unroll") for(int r=0;r<16;++r)pA0[r]=__builtin_amdgcn_exp2f(fsub_s(pA0[r],mhat));
    _Pragma("unroll") for(int r=0;r<16;++r)pA1[r]=__builtin_amdgcn_exp2f(fsub_s(pA1[r],mhat)); }
  asm volatile("s_waitcnt vmcnt(0) lgkmcnt(0)\n\ts_barrier":::"memory");
  DMA_K(3,0);DMA_V(1,SLOTB);
  ROT();
  kload8(kf,kp0+sl_cur);
  asm volatile("s_waitcnt vmcnt(3) lgkmcnt(0)\n\ts_barrier":::"memory");
  s16x4 vlo[8],vhi[8]; u32x4 pw0,pw1,pw2,pw3;
  #define PKW(P,B) cvtpk_s(P[B],P[B+1])
  #define PAF(k) __builtin_bit_cast(bf16x8,pw##k)
  #define VFR(i) (bf16x8){vlo[i][0],vlo[i][1],vlo[i][2],vlo[i][3],vhi[i][0],vhi[i][1],vhi[i][2],vhi[i][3]}
  #define PIN(x) asm volatile("":"+v"(x))
  #define MX3(a,b,c) __builtin_fmaxf(__builtin_fmaxf((a),(b)),(c))
  #define GAPA(MF,A0,A1,A2,A3,W0,W1,PW) do{ MF; sacc+=A0; sacc+=A1; sacc+=A2; sacc+=A3; PIN(sacc); W0; W1; PIN(PW); SBAR(); }while(0)
  #define EXM(v) __builtin_amdgcn_exp2f(fsub_s((v),mhat))
  #define GAPB(MF,X,B) do{ MF; X[B]=EXM(X[B]); X[B+1]=EXM(X[B+1]); PIN(X); SBAR(); }while(0)
  #define VRD(i) do{ vlo[i]=vtr(vp_+(((i)>>2)*4096+((i)&3)*1024)); vhi[i]=vtr(vp_+(((i)>>2)*4096+((i)&3)*1024+512)); }while(0)
  #define VRD2(i) do{ vlo[i]=vtr(vp_+(8192+((i)>>2)*4096+((i)&3)*1024)); vhi[i]=vtr(vp_+(8192+((i)>>2)*4096+((i)&3)*1024+512)); SBAR(); }while(0)
  #define KRD(G,j) do{ if(G){ kload2(kf,kp0+sl_next,j); SBAR(); } }while(0)
  #define STEP(C0,C1,P0,P1,t,GK,GV,GL) do{ SBAR(); \
    const lds_cptr vp_=vp0+2*sl_prev; \
    VRD(0); SBAR(); float sacc=(P0[0]+P0[1]); \
    GAPA(C0=__builtin_amdgcn_mfma_f32_32x32x16_bf16(kf[0],qr[0],z16,0,0,0), P0[2],P0[3],P0[4],P0[5],     pw0[0]=PKW(P0,0), pw0[1]=PKW(P0,2), pw0); \
    VRD(4); SBAR(); GAPA(C1=__builtin_amdgcn_mfma_f32_32x32x16_bf16(kf[1],qr[0],z16,0,0,0), P0[6],P0[7],P0[8],P0[9],     pw0[2]=PKW(P0,4), pw0[3]=PKW(P0,6), pw0); \
    VRD(1); SBAR(); GAPA(C0=__builtin_amdgcn_mfma_f32_32x32x16_bf16(kf[2],qr[1],C0,0,0,0),   P0[10],P0[11],P0[12],P0[13], pw1[0]=PKW(P0,8), pw1[1]=PKW(P0,10), pw1); \
    VRD(5); SBAR(); GAPA(C1=__builtin_amdgcn_mfma_f32_32x32x16_bf16(kf[3],qr[1],C1,0,0,0),   P0[14],P0[15],P1[0],P1[1],   pw1[2]=PKW(P0,12),pw1[3]=PKW(P0,14), pw1); \
    VRD(2); SBAR(); GAPA(C0=__builtin_amdgcn_mfma_f32_32x32x16_bf16(kf[4],qr[2],C0,0,0,0),   P1[2],P1[3],P1[4],P1[5],     pw2[0]=PKW(P1,0), pw2[1]=PKW(P1,2), pw2); \
    VRD(6); SBAR(); GAPA(C1=__builtin_amdgcn_mfma_f32_32x32x16_bf16(kf[5],qr[2],C1,0,0,0),   P1[6],P1[7],P1[8],P1[9],     pw2[2]=PKW(P1,4), pw2[3]=PKW(P1,6), pw2); \
    VRD(3); SBAR(); GAPA(C0=__builtin_amdgcn_mfma_f32_32x32x16_bf16(kf[6],qr[3],C0,0,0,0),   P1[10],P1[11],P1[12],P1[13], pw3[0]=PKW(P1,8), pw3[1]=PKW(P1,10), pw3); \
    VRD(7); SBAR(); GAPA(C1=__builtin_amdgcn_mfma_f32_32x32x16_bf16(kf[7],qr[3],C1,0,0,0),   P1[14],P1[15],0.f,0.f,       pw3[2]=PKW(P1,12),pw3[3]=PKW(P1,14), pw3); \
    l_reg+=sacc; \
    if(GK){DMA_K((t)+3,sl_cur);} if(GV){DMA_V((t)+1,sl_next);} \
    CMASK(C0,C1,t); \
    { float a=MX3(C0[0],C0[1],C1[0]),b=MX3(C0[2],C0[3],C1[1]); a=MX3(a,C1[2],C1[3]); \
      _Pragma("unroll") for(int r=4;r<16;r+=4){a=MX3(a,C0[r],C0[r+1]);b=MX3(b,C0[r+2],C0[r+3]);a=MX3(a,C1[r],C1[r+1]);b=MX3(b,C1[r+2],C1[r+3]);} \
      float rm=__builtin_fmaxf(a,b); { auto rr=__builtin_amdgcn_permlane32_swap(__float_as_uint(rm),__float_as_uint(rm),false,false); rm=__builtin_fmaxf(__uint_as_float(rr[0]),__uint_as_float(rr[1])); } \
      resc=false; const float gr_=rm-mhat; \
      if(__builtin_expect(__any(gr_>(float)THRL),0)){ const float dl=__builtin_fmaxf(gr_,0.f); mhat+=dl; \
        const float f=__builtin_amdgcn_exp2f(-dl); l_reg*=f; if(hi==0)wsf[r32]=f; resc=true; } } \
    SBAR(); \
    GAPB(o[0]=__builtin_amdgcn_mfma_f32_32x32x16_bf16(PAF(0),VFR(0),o[0],0,0,0), C0,0);  VRD2(0); \
    GAPB(o[1]=__builtin_amdgcn_mfma_f32_32x32x16_bf16(PAF(0),VFR(4),o[1],0,0,0), C0,2);  VRD2(4); \
    GAPB(o[0]=__builtin_amdgcn_mfma_f32_32x32x16_bf16(PAF(1),VFR(1),o[0],0,0,0), C0,4);  VRD2(1); \
    GAPB(o[1]=__builtin_amdgcn_mfma_f32_32x32x16_bf16(PAF(1),VFR(5),o[1],0,0,0), C0,6);  VRD2(5); \
    GAPB(o[0]=__builtin_amdgcn_mfma_f32_32x32x16_bf16(PAF(2),VFR(2),o[0],0,0,0), C0,8);  VRD2(2); \
    GAPB(o[1]=__builtin_amdgcn_mfma_f32_32x32x16_bf16(PAF(2),VFR(6),o[1],0,0,0), C0,10); VRD2(6); \
    GAPB(o[0]=__builtin_amdgcn_mfma_f32_32x32x16_bf16(PAF(3),VFR(3),o[0],0,0,0), C0,12); VRD2(3); \
    GAPB(o[1]=__builtin_amdgcn_mfma_f32_32x32x16_bf16(PAF(3),VFR(7),o[1],0,0,0), C0,14); VRD2(7); \
    GAPB(o[2]=__builtin_amdgcn_mfma_f32_32x32x16_bf16(PAF(0),VFR(0),o[2],0,0,0), C1,0); \
    GAPB(o[3]=__builtin_amdgcn_mfma_f32_32x32x16_bf16(PAF(0),VFR(4),o[3],0,0,0), C1,2); \
    KRD(GL,0); GAPB(o[2]=__builtin_amdgcn_mfma_f32_32x32x16_bf16(PAF(1),VFR(1),o[2],0,0,0), C1,4); \
    KRD(GL,1); GAPB(o[3]=__builtin_amdgcn_mfma_f32_32x32x16_bf16(PAF(1),VFR(5),o[3],0,0,0), C1,6); \
    KRD(GL,2); GAPB(o[2]=__builtin_amdgcn_mfma_f32_32x32x16_bf16(PAF(2),VFR(2),o[2],0,0,0), C1,8); \
    KRD(GL,3); GAPB(o[3]=__builtin_amdgcn_mfma_f32_32x32x16_bf16(PAF(2),VFR(6),o[3],0,0,0), C1,10); \
    GAPB(o[2]=__builtin_amdgcn_mfma_f32_32x32x16_bf16(PAF(3),VFR(3),o[2],0,0,0), C1,12); \
    GAPB(o[3]=__builtin_amdgcn_mfma_f32_32x32x16_bf16(PAF(3),VFR(7),o[3],0,0,0), C1,14); \
    }while(0)
  #define WB3() asm volatile("s_waitcnt vmcnt(3) lgkmcnt(0)\n\ts_barrier":::"memory")
  #define WB2() asm volatile("s_waitcnt vmcnt(2) lgkmcnt(0)\n\ts_barrier":::"memory")
  #define WB0() asm volatile("s_waitcnt vmcnt(0) lgkmcnt(0)\n\ts_barrier":::"memory")
  int t=1;
  #undef CMASK
  #define CMASK(P0,P1,t) do{}while(0)
  for(;t+5<NT;t+=2){
    STEP(pB0,pB1,pA0,pA1,t,true,true,true);     WB3(); RESC(); ROT();
    STEP(pA0,pA1,pB0,pB1,t+1,true,true,true);   WB3(); RESC(); ROT();
  }
  #undef CMASK
  #define CMASK(P0,P1,t) do{int jb_=(t)-(NT-4); if(jb_>=0)cmask(P0,P1,jb_,qrel,hi);}while(0)
  #define ENDW(tt) do{ if((tt)+3<NT){WB3();} else if((tt)+2<NT){WB2();} else {WB0();} }while(0)
  for(;t+1<NT;t+=2){
    STEP(pB0,pB1,pA0,pA1,t,(t+3<NT),(t+1<NT),(t+1<NT));       ENDW(t);   RESC(); ROT();
    STEP(pA0,pA1,pB0,pB1,t+1,(t+4<NT),(t+2<NT),(t+2<NT));     ENDW(t+1); RESC(); ROT();
  }
  STEP(pB0,pB1,pA0,pA1,NT-1,false,false,false); RESC();
  { float sacc=pB0[0]+pB0[1]; _Pragma("unroll") for(int r=2;r<16;++r)sacc+=pB0[r]; _Pragma("unroll") for(int r=0;r<16;++r)sacc+=pB1[r]; l_reg+=sacc;
    pw0=(u32x4){PKW(pB0,0),PKW(pB0,2),PKW(pB0,4),PKW(pB0,6)};pw1=(u32x4){PKW(pB0,8),PKW(pB0,10),PKW(pB0,12),PKW(pB0,14)};pw2=(u32x4){PKW(pB1,0),PKW(pB1,2),PKW(pB1,4),PKW(pB1,6)};pw3=(u32x4){PKW(pB1,8),PKW(pB1,10),PKW(pB1,12),PKW(pB1,14)};
    SBAR(); pv128(o,vb0+2*sl_cur,PAF(0),PAF(1),PAF(2),PAF(3)); }
  #undef PKW
  #undef PAF
  #undef VFR
  #undef PIN
  #undef MX3
  #undef GAPA
  #undef GAPB
  #undef EXM
  #undef VRD
  #undef VRD2
  #undef KRD
  #undef STEP
  #undef ENDW
  #undef WB3
  #undef WB2
  #undef WB0
  {auto rr=__builtin_amdgcn_permlane32_swap(__float_as_uint(l_reg),__float_as_uint(l_reg),false,false);l_reg=__uint_as_float(rr[0])+__uint_as_float(rr[1]);}
  if(hi==0)wsf[32+r32]=l_reg;asm volatile("s_waitcnt lgkmcnt(0)":::"memory");
  float rli[16];
  #pragma unroll
  for(int r=0;r<16;++r)rli[r]=__builtin_amdgcn_rcpf(wsf[32+crow(r,hi)]);
  int lane_e=lane; asm volatile("":"+v"(lane_e));
  bf16*Ow=O+gsl+pq0+(long)(wid*QBLK)*PO+co;
  { bf16*stg=(bf16*)(shm+L2_OST)+wid*2048;
    #pragma unroll
    for(int hf=0;hf<2;++hf){
      #pragma unroll
      for(int r=0;r<16;++r){const int orow=crow(r,hi);
        #pragma unroll
        for(int d0=0;d0<2;++d0)stg[orow*64+d0*32+r32]=__float2bfloat16(o[2*hf+d0][r]*rli[r]);}
      asm volatile("s_waitcnt lgkmcnt(0)":::"memory");
      #pragma unroll
      for(int i=0;i<4;++i){const int row=i*8+(lane_e>>3),ch=lane_e&7; const u32x4 v=*(const u32x4*)(stg+row*64+ch*8); ATTN_STORE16(Ow+(long)row*PO+hf*64+ch*8,v);}
      asm volatile("s_waitcnt lgkmcnt(0)":::"memory"); } }
  asm volatile("s_waitcnt lgkmcnt(0)\n\ts_barrier":::"memory");
  #undef DMA_K
  #undef TOFF
  #undef DMA_V
  #undef CMASK
  #undef RESC
  #undef ROT
}
constexpr int ATTN_LDS_BYTES=LDS_BYTES;
#undef SBAR
#undef WAIT_BAR
}

constexpr int NWAVES = 8;
constexpr size_t MiB = 1u << 20;
constexpr size_t WS_CTL = 0, CTL_ZERO_BYTES = 3 * MiB;
constexpr size_t WS_ROWSS = 1 * MiB;
constexpr size_t WS_CS = 492 * MiB;
constexpr size_t WS_W = 4 * MiB, W_LAYER = 32 * MiB;
constexpr size_t WO_IN = 0, WO_MIX = 6 * MiB, WO_QG = 8 * MiB, WO_O = 10 * MiB, WO_KV = 12 * MiB, WO_1 = 16 * MiB, WO_2 = 24 * MiB;
constexpr size_t WS_MEMN = 68 * MiB;
constexpr size_t WS_KV = 76 * MiB, KV_LAYER = 16 * MiB;
constexpr size_t WS_WQK = 108 * MiB, WS_VWO = 140 * MiB;
constexpr size_t WS_HB = 172 * MiB;
constexpr size_t WS_X = 236 * MiB;
constexpr size_t KiB = 1024;
constexpr size_t X_Q = 0, X_K = 256 * KiB, X_V = 512 * KiB, X_BG = 768 * KiB, X_U = 1024 * KiB, X_O = 1280 * KiB, X_MIX = 0, X_P = 512 * KiB, X_F = 0;
constexpr size_t WS_END = 494 * MiB;
constexpr int CW_BAR = 4096;

constexpr int RING_OFF = 0, RING_BYTES = 131072;
constexpr int LDSCTL_OFF = RING_BYTES, MISC_OFF = LDSCTL_OFF + 320, EPIX_OFF = RING_BYTES + 1024;
constexpr int LDS_BYTES = 147456;
static_assert(EPIX_OFF + 8192 <= LDS_BYTES && MISC_OFF + 128 <= EPIX_OFF, "LDS map");

#define GAS __attribute__((address_space(1)))
#define LAS __attribute__((address_space(3)))
typedef unsigned short bf16;
typedef unsigned v4u __attribute__((ext_vector_type(4)));
typedef unsigned v2u __attribute__((ext_vector_type(2)));
typedef float f32x4 __attribute__((ext_vector_type(4)));
typedef GAS unsigned gu32;
#define RLX_AGENT __ATOMIC_RELAXED, __HIP_MEMORY_SCOPE_AGENT
#define LDS_WAIT() asm volatile("s_waitcnt lgkmcnt(0)" ::: "memory")
#define VM_WAIT() asm volatile("s_waitcnt vmcnt(0)" ::: "memory")
__device__ __forceinline__ unsigned f2bf(float f) { unsigned u = __builtin_bit_cast(unsigned, f); return (u + 0x7fffu + ((u >> 16) & 1u)) >> 16; }
__device__ __forceinline__ unsigned pk2(float lo, float hi) { return f2bf(lo) | (f2bf(hi) << 16); }
__device__ __forceinline__ float bflo(unsigned w) { return __uint_as_float(w << 16); }
__device__ __forceinline__ float bfhi(unsigned w) { return __uint_as_float(w & 0xffff0000u); }

#define XB_TMO      128
#define XB_XCNT(j)  (256  + 64 * (j))
#define XB_XSUB(j)  (1280 + 64 * (j))
#define XB_XGEN(j)  (2304 + 64 * (j))
#define XB_TOP      3328
#define XB_TOPGEN   3392
#define XCD_BAR_WORDS 3456
#define XB_LSUB(j)  (3520 + 64 * (j))
#define XB_XID(w)   (4608 + (w))
#define XB_PAIR(i)  (8192 + 16 * (i))
#define XB_BAD      4928
#define XB_SPIN_CAP (1u << 18)
__device__ __forceinline__ unsigned xb_ld(unsigned* p)              { return __hip_atomic_load(p, __ATOMIC_RELAXED, __HIP_MEMORY_SCOPE_AGENT); }
__device__ __forceinline__ unsigned xb_add(unsigned* p, unsigned v) { return __hip_atomic_fetch_add(p, v, __ATOMIC_RELAXED, __HIP_MEMORY_SCOPE_AGENT); }
__device__ __forceinline__ unsigned xb_xcc_id() { return (unsigned)__builtin_amdgcn_s_getreg((3 << 11) | 20) & 0xFu; }
#define XB_SPIN(cond, bar) do { unsigned _sp = 0; while (cond) { __builtin_amdgcn_s_sleep(1); \
    if ((++_sp & 255u) == 0u) { if (xb_ld(&(bar)[XB_TMO])) break; if (_sp > XB_SPIN_CAP) { atomicAdd(&(bar)[XB_TMO], 1u); break; } } } } while (0)
struct XcdBarrier { unsigned* bar; unsigned x; volatile LAS unsigned* st; };
__device__ __forceinline__ XcdBarrier xcd_barrier_post(unsigned* bar, volatile LAS unsigned* st) {
    XcdBarrier b; b.bar = bar; b.x = xb_xcc_id(); b.st = st;
    if (threadIdx.x == 0) (void)xb_add(&bar[XB_XCNT(b.x)], 1u);
    return b;
}
__device__ __forceinline__ void xcd_barrier_complete(unsigned* bar, unsigned x, unsigned& nloc, unsigned& nx) {
    const unsigned G = gridDim.x * gridDim.y * gridDim.z;
    unsigned sum, cnt, mine, sp = 0u;
    for (;;) {
        sum = 0u; cnt = 0u; mine = 0u;
#pragma unroll
        for (unsigned j = 0; j < 16; ++j) { const unsigned c = xb_ld(&bar[XB_XCNT(j)]); sum += c; cnt += (c > 0u) ? 1u : 0u; }
        mine = xb_ld(&bar[XB_XCNT(x)]);
        if (sum == G) break;
        __builtin_amdgcn_s_sleep(1);
        if ((++sp & 255u) == 0u) { if (xb_ld(&bar[XB_TMO])) break; if (sp > XB_SPIN_CAP) { atomicAdd(&bar[XB_TMO], 1u); break; } }
    }
    nloc = mine > 0u ? mine : 1u; nx = cnt > 0u ? cnt : 1u;
}
__device__ __forceinline__ void xcd_barrier(const XcdBarrier& b, const bool leader) {
    asm volatile("s_waitcnt vmcnt(0)" ::: "memory");
    __syncthreads();
    if (leader) {
        unsigned* bar = b.bar;
        __builtin_amdgcn_s_waitcnt(0);
        unsigned nloc = b.st[0], nx = b.st[1];
        if (nloc == 0u) { xcd_barrier_complete(bar, b.x, nloc, nx); b.st[0] = nloc; b.st[1] = nx; }
        const unsigned old = xb_add(&bar[XB_XSUB(b.x)], 1u);
        const unsigned gen = old / nloc;
        if (old + 1u == (gen + 1u) * nloc) {
            __builtin_amdgcn_fence(__ATOMIC_RELEASE, "agent");
            asm volatile("s_waitcnt vmcnt(0)" ::: "memory");
            const unsigned og = xb_add(&bar[XB_TOP], 1u);
            const unsigned tg = og / nx;
            if (og + 1u == (tg + 1u) * nx) xb_add(&bar[XB_TOPGEN], 1u);
            else XB_SPIN(xb_ld(&bar[XB_TOPGEN]) == tg, bar);
            __builtin_amdgcn_fence(__ATOMIC_ACQUIRE, "agent");
            xb_add(&bar[XB_XGEN(b.x)], 1u);
            asm volatile("s_waitcnt vmcnt(0)" ::: "memory");
        } else {
            XB_SPIN(xb_ld(&bar[XB_XGEN(b.x)]) == gen, bar);
            __builtin_amdgcn_fence(__ATOMIC_ACQUIRE, "agent");
            asm volatile("s_waitcnt vmcnt(0)" ::: "memory");
        }
    }
    __syncthreads();
}

__device__ __forceinline__ void pair_barrier(const XcdBarrier& b, const bool leader, const int pi) {
    asm volatile("s_waitcnt vmcnt(0)" ::: "memory");
    __syncthreads();
    if (leader) {
        unsigned* bar = b.bar;
        __builtin_amdgcn_s_waitcnt(0);
        const unsigned k = b.st[3] + 1u; b.st[3] = k;
        const unsigned target = 2u * k;
        (void)__hip_atomic_fetch_add(&bar[XB_PAIR(pi)], 1u, __ATOMIC_RELAXED, __HIP_MEMORY_SCOPE_AGENT);
        XB_SPIN(xb_ld(&bar[XB_PAIR(pi)]) < target, bar);
        __builtin_amdgcn_fence(__ATOMIC_ACQUIRE, "agent");
        asm volatile("s_waitcnt vmcnt(0)" ::: "memory");
    }
    __syncthreads();
}

__device__ __forceinline__ void xcc_barrier(const XcdBarrier& b, const bool leader) {
    asm volatile("s_waitcnt vmcnt(0)" ::: "memory");
    __syncthreads();
    if (leader) {
        unsigned* bar = b.bar;
        __builtin_amdgcn_s_waitcnt(0);
        const unsigned nloc = b.st[0];
        const unsigned k = b.st[2] + 1u; b.st[2] = k;
        const unsigned target = k * nloc;
        (void)__hip_atomic_fetch_add(&bar[XB_LSUB(b.x)], 1u, __ATOMIC_RELAXED, __HIP_MEMORY_SCOPE_AGENT);
        XB_SPIN(xb_ld(&bar[XB_LSUB(b.x)]) < target, bar);
        __builtin_amdgcn_fence(__ATOMIC_ACQUIRE, "agent");
        asm volatile("s_waitcnt vmcnt(0)" ::: "memory");
    }
    __syncthreads();
}

struct Frame {
    LAS unsigned char* lds;
    int tid, lane, wave, vcu, G, bx;
};
__device__ __forceinline__ float shx(float x, int mask) { unsigned on_ = ~0u; asm volatile("" : "+s"(on_)); const int l = (int)__builtin_amdgcn_mbcnt_hi(on_, __builtin_amdgcn_mbcnt_lo(on_, 0u));
    return __builtin_bit_cast(float, __builtin_amdgcn_ds_bpermute((l ^ mask) << 2, __builtin_bit_cast(int, x))); }
__device__ __forceinline__ float wave_sum(float v) {
#pragma unroll
    for (int o = 1; o < 64; o <<= 1) v += shx(v, o);
    return v;
}

__device__ __forceinline__ void p0_transpose_item(const float* W, int K, int N, bf16* WT, int dst_row0, const float* g, LAS float* scr, int kb, int nb, int lane, const bool tiled) {
    const int k0 = 64 * kb, n0 = 32 * nb;
    float wv[32];
#pragma unroll
    for (int i = 0; i < 32; ++i) { const int kk = 2 * i + (lane >> 5); wv[i] = W[(size_t)(k0 + kk) * N + n0 + (lane & 31)]; }
#pragma unroll
    for (int i = 0; i < 32; ++i) { const int kk = 2 * i + (lane >> 5); float w = wv[i]; if (g) w *= g[k0 + kk]; scr[kk * 33 + (lane & 31)] = w; }
    LDS_WAIT(); asm volatile("" ::: "memory");
    const int c = lane & 7;
#pragma unroll
    for (int j = 0; j < 4; ++j) { const int n = (lane >> 3) + 8 * j; const LAS float* s = scr + (8 * c) * 33 + n;
        v4u o; o.x = pk2(s[0 * 33], s[1 * 33]); o.y = pk2(s[2 * 33], s[3 * 33]); o.z = pk2(s[4 * 33], s[5 * 33]); o.w = pk2(s[6 * 33], s[7 * 33]);
        const size_t off = tiled ? pg8::btile_off(dst_row0 + n, k0 + 8 * c, K) : (size_t)(dst_row0 + n) * K + k0 + 8 * c;
        *(GAS v4u*)(WT + off) = o; }
    LDS_WAIT(); asm volatile("" ::: "memory");
}
__device__ __forceinline__ int win_dst_row(int n) {
    if (n < 2048) return n;
    if (n < 2560) { const int ch = n - 2048; return 2048 + 256 * (ch >> 7) + (ch & 127); }
    const int ch = n - 2560; return 2048 + 256 * (ch >> 7) + 128 + (ch & 127);
}
__device__ __forceinline__ void sincos_d(double x, float& s, float& c) {
    const double k = __builtin_rint(x * 0.63661977236758134308);
    double r = __builtin_fma(-k, 1.57079632679489655800e+00, x); r = __builtin_fma(-k, 6.12323399573676603587e-17, r);
    const double r2 = r * r;
    double sp = -7.6471637318198164759e-13; sp = sp * r2 + 1.6059043836821614599e-10; sp = sp * r2 - 2.5052108385441718775e-08; sp = sp * r2 + 2.7557319223985890653e-06;
    sp = sp * r2 - 1.9841269841269841270e-04; sp = sp * r2 + 8.3333333333333333333e-03; sp = sp * r2 - 1.6666666666666666667e-01; const double sn = r + r * r2 * sp;
    double cp = 4.7794773323873852974e-14; cp = cp * r2 - 1.1470745597729724714e-11; cp = cp * r2 + 2.0876756987868098979e-09; cp = cp * r2 - 2.7557319223985890653e-07;
    cp = cp * r2 + 2.4801587301587301587e-05; cp = cp * r2 - 1.3888888888888888889e-03; cp = cp * r2 + 4.1666666666666666667e-02; const double cn = 1.0 - 0.5 * r2 + r2 * r2 * cp;
    const int q = ((int)(long long)k) & 3;
    const double ss = (q == 0) ? sn : (q == 1) ? cn : (q == 2) ? -sn : -cn;
    const double cc = (q == 0) ? cn : (q == 1) ? -sn : (q == 2) ? -cn : sn;
    s = (float)ss; c = (float)cc;
}

struct Args { const void* in[21]; float* out; unsigned char* ws; int ph_lo, ph_hi, li, pad; };
constexpr int NPH = 18;

#ifndef PROBE_REP
#define PROBE_REP -1
#endif
#define NREP(k) ((PROBE_REP == (k)) ? 2 : 1)
#ifndef PH_MASK
#define PH_MASK 0xfff
#endif
#define PHON(k) (((PH_MASK) >> (k)) & 1)
#define INP(i) ((const float*)args.in[i])
#define WSP(T, off) ((T*)((GAS T*)(wsb + (off))))
__global__ void __launch_bounds__(NWAVES * 64, 2) fwd_kernel(Args args) {
    extern __shared__ __attribute__((aligned(16))) unsigned char lds[];
    Frame F;
    F.lds = (LAS unsigned char*)lds;
    volatile LAS unsigned* MISC = (volatile LAS unsigned*)(F.lds + MISC_OFF);
    F.tid = threadIdx.x; F.lane = F.tid & 63; F.wave = __builtin_amdgcn_readfirstlane(F.tid >> 6);
    const int wave0 = F.wave;
    F.G = gridDim.x; { const int bx = blockIdx.x; F.bx = bx; F.vcu = (F.G % 8 == 0) ? (bx % 8) * (F.G / 8) + bx / 8 : bx; }
    for (int u = F.tid; u < (LDS_BYTES - LDSCTL_OFF) / 4; u += NWAVES * 64) ((LAS unsigned*)(F.lds + LDSCTL_OFF))[u] = 0u;
    __syncthreads();
    XcdBarrier bar; bar.bar = (unsigned*)(args.ws + WS_CTL) + CW_BAR; bar.x = 0; bar.st = nullptr;
    if (!MK_PER_PHASE) { bar = xcd_barrier_post((unsigned*)(args.ws + WS_CTL) + CW_BAR, MISC + 8);
        if (threadIdx.x == 0) __hip_atomic_store(bar.bar + XB_XID(blockIdx.x), bar.x + 1u, RLX_AGENT); }
    bool local_ok = false;

    if (args.ph_lo == 0) {
        GAS unsigned char* wsb = (GAS unsigned char*)args.ws;
        const int gw = F.vcu * NWAVES + F.wave, NGW = F.G * NWAVES;
        for (int rp = 0; rp < NREP(0); ++rp) { if (PHON(0)) {
            LAS float* scr = (LAS float*)(F.lds + RING_OFF + F.wave * 16384);
            constexpr int I_IN = 16 * 96, I_MIX = 16 * 32, I_O = 16 * 32, I_KV = 16 * 64, I_1 = 16 * 128, I_2 = 64 * 32, I_L = I_IN + I_MIX + I_O + I_KV + I_1 + I_2;
            for (int it = gw; it < DEPTH * I_L; it += NGW) {
                const int l = it / I_L; int r = it % I_L; unsigned char* wl = (unsigned char*)(wsb + WS_W + (size_t)l * W_LAYER);
                if (r < I_IN) { const int kb = r / 96, nb = r % 96; p0_transpose_item(INP(4) + (size_t)l * DM * INC, DM, INC, (bf16*)(wl + WO_IN), win_dst_row(32 * nb), INP(3) + l * DM, scr, kb, nb, F.lane, true); continue; } r -= I_IN;
                if (r < I_MIX) { const int kb = r / 32, nb = r % 32; p0_transpose_item(INP(11) + (size_t)l * DM * DM, DM, DM, (bf16*)(wl + WO_MIX), 32 * nb, nullptr, scr, kb, nb, F.lane, true); continue; } r -= I_MIX;
                if (r < I_O) { const int kb = r / 32, nb = r % 32; p0_transpose_item(INP(16) + (size_t)l * DM * DM, DM, DM, (bf16*)(wl + WO_O), 32 * nb, nullptr, scr, kb, nb, F.lane, false); continue; } r -= I_O;
                if (r < I_KV) { const int kb = r / 64, nb = r % 64; p0_transpose_item(INP(15) + (size_t)l * DM * 2 * DM, DM, 2 * DM, (bf16*)(wl + WO_KV), 32 * nb, nullptr, scr, kb, nb, F.lane, true); continue; } r -= I_KV;
                if (r < I_1) { const int kb = r / 128, nb = r % 128; p0_transpose_item(INP(18) + (size_t)l * DM * FF, DM, FF, (bf16*)(wl + WO_1), 32 * nb, INP(17) + l * DM, scr, kb, nb, F.lane, true); continue; } r -= I_1;
                { const int kb = r / 32, nb = r % 32; p0_transpose_item(INP(19) + (size_t)l * FF * DM, FF, DM, (bf16*)(wl + WO_2), 32 * nb, nullptr, scr, kb, nb, F.lane, true); }
            }
            { const int gt = F.vcu * (NWAVES * 64) + F.tid, NGT = F.G * NWAVES * 64;
              const float* w_xq = INP(14); const float* norm_x_g = INP(12);
              for (int it = gt; it < DEPTH * DM * DM / 8; it += NGT) { const int l = it / (DM * DM / 8), e = (it % (DM * DM / 8)) * 8, k = e / DM;
                  const f32x4 a = *(const f32x4*)(w_xq + (size_t)l * DM * DM + e), b = *(const f32x4*)(w_xq + (size_t)l * DM * DM + e + 4); const float g = norm_x_g[l * DM + k];
                  v4u o; o.x = pk2(a[0] * g, a[1] * g); o.y = pk2(a[2] * g, a[3] * g); o.z = pk2(b[0] * g, b[1] * g); o.w = pk2(b[2] * g, b[3] * g);
                  *((GAS v4u*)(wsb + WS_W + (size_t)l * W_LAYER + WO_QG + (size_t)e * 2)) = o; }
              const int* positions = (const int*)args.in[2]; float* cstab = WSP(float, WS_CS);
              for (int it = gt; it < MTOK * 8; it += NGT) { const int row = it >> 3, i = it & 7;
                  double f = 1.0;
                  f = (i == 1) ? 0.19392274474868576 : f; f = (i == 2) ? 0.03760603093086393 : f; f = (i == 3) ? 0.007292664737217109 : f; f = (i == 4) ? 0.001414213562373095 : f;
                  f = (i == 5) ? 0.0002742481756762073 : f; f = (i == 6) ? 5.318295896944988e-05 : f; f = (i == 7) ? 1.031338537721246e-05 : f;
                  float s, c; sincos_d((double)positions[row] * f, s, c); cstab[(size_t)row * 16 + i] = c; cstab[(size_t)row * 16 + 8 + i] = s; }
            }
            { const float* x = INP(0); pg8::rss_t* rowss = WSP(pg8::rss_t, WS_ROWSS); bf16* HB = WSP(bf16, WS_HB); float* out = args.out;
            for (int rb = gw; rb < MTOK / 16; rb += NGW) {
                const int m = rb * 16 + (F.lane >> 2), c4 = F.lane & 3; const float* xr = x + (size_t)m * DM + c4 * 8; bf16* pan = HB + (size_t)(m >> 8) * 256 * DM; float s = 0.f;
#pragma unroll 8
                for (int g = 0; g < 32; ++g) { const f32x4 a = *(const GAS f32x4*)(xr + g * 32), b2 = *(const GAS f32x4*)(xr + g * 32 + 4);
                    s += (a.x * a.x + a.y * a.y) + (a.z * a.z + a.w * a.w) + (b2.x * b2.x + b2.y * b2.y) + (b2.z * b2.z + b2.w * b2.w);
                    v4u o; o.x = pk2(a.x, a.y); o.y = pk2(a.z, a.w); o.z = pk2(b2.x, b2.y); o.w = pk2(b2.z, b2.w);
                    *(GAS v4u*)(pan + pg8::atile_off(m & 255, g * 32 + c4 * 8)) = o; }
                s += shx(s, 1); s += shx(s, 2);
                if (c4 == 0) rowss[m] = pg8::rss_fix(s);
            } }
            { const float* mem = INP(1); const float* mem_norm_g = INP(13); bf16* MEMN = WSP(bf16, WS_MEMN);
            for (int m = gw; m < MMEM; m += NGW) {
                const GAS f32x4* xr = (const GAS f32x4*)(mem + (size_t)m * DM) + F.lane; f32x4 v[4]; float s = 0.f;
#pragma unroll
                for (int j = 0; j < 4; ++j) { v[j] = xr[64 * j]; s += (v[j].x * v[j].x + v[j].y * v[j].y) + (v[j].z * v[j].z + v[j].w * v[j].w); }
                const float r = 1.0f / sqrtf(wave_sum(s) * (1.0f / DM) + NORM_EPS);
                GAS v2u* o8 = (GAS v2u*)(MEMN + (size_t)m * DM) + F.lane;
#pragma unroll
                for (int j = 0; j < 4; ++j) { const f32x4 g = *((const f32x4*)mem_norm_g + F.lane + 64 * j); v2u w; w.x = pk2(v[j].x * r * g.x, v[j].y * r * g.y); w.y = pk2(v[j].z * r * g.z, v[j].w * r * g.w); o8[64 * j] = w; }
            } }
        } }
        if (!MK_PER_PHASE && 1 < args.ph_hi) xcd_barrier(bar, F.tid == 0);
    }
    for (int ph0 = (args.ph_lo > 1 ? args.ph_lo : 1); ph0 < args.ph_hi; ++ph0) {
      const int ptype = (ph0 == NPH - 1) ? 9 : 1 + (ph0 - 1) % 8; const int nrep = (ptype == PROBE_REP) ? 2 : 1;
      for (int rp = 0; rp < nrep; ++rp) {
        int ph = ph0; asm volatile("" : "+s"(ph));
#define PHASE_TID() do { unsigned ones_ = ~0u; asm volatile("" : "+s"(ones_)); int t_ = (wave0 << 6) | (int)__builtin_amdgcn_mbcnt_hi(ones_, __builtin_amdgcn_mbcnt_lo(ones_, 0u)); asm volatile("" : "+v"(t_)); F.tid = t_; F.lane = t_ & 63; } while (0)
        { F.wave = wave0; int bx_ = blockIdx.x, g_ = gridDim.x; asm volatile("" : "+s"(bx_), "+s"(g_)); F.G = g_; F.bx = bx_; F.vcu = (g_ % 8 == 0) ? (bx_ % 8) * (g_ / 8) + bx_ / 8 : bx_; }
        GAS unsigned char* wsb = (GAS unsigned char*)args.ws; asm volatile("" : "+s"(wsb));
        const int gw = F.vcu * NWAVES + F.wave, NGW = F.G * NWAVES;
        if (ph == NPH - 1) { { PHASE_TID();
            const pg8::rss_t* rs_fin = WSP(pg8::rss_t, WS_ROWSS) + (size_t)6 * MTOK; const float* final_g = INP(20); float* out = args.out;
            const bool dead = (!MK_PER_PHASE) && (xb_ld(WSP(unsigned, WS_CTL) + CW_BAR + XB_TMO) != 0u);
            { const int m = gw * 16 + (F.lane >> 2), c4 = F.lane & 3;
                const float r = pg8::rstd_of(rs_fin, m); const bf16* pan = WSP(bf16, WS_HB) + (size_t)(m >> 8) * 256 * DM; float* orow = out + (size_t)m * DM + c4 * 8;
#pragma unroll 8
                for (int g = 0; g < 32; ++g) { const v4u w = *(const GAS v4u*)(pan + pg8::atile_off(m & 255, g * 32 + c4 * 8));
                    const f32x4 g0 = *(const f32x4*)(final_g + g * 32 + c4 * 8), g1 = *(const f32x4*)(final_g + g * 32 + c4 * 8 + 4);
                    f32x4 v0 = (f32x4){bflo(w.x), bfhi(w.x), bflo(w.y), bfhi(w.y)} * r * g0, v1 = (f32x4){bflo(w.z), bfhi(w.z), bflo(w.w), bfhi(w.w)} * r * g1;
                    if (dead) { v0 = (f32x4){NAN, NAN, NAN, NAN}; v1 = v0; }
                    *(GAS f32x4*)(orow + g * 32) = v0; *(GAS f32x4*)(orow + g * 32 + 4) = v1; }
            }
        } } else {
            const int l = (ph - 1) / 8, j = (ph - 1) % 8;
            unsigned char* wl = (unsigned char*)(wsb + WS_W + (size_t)l * W_LAYER);
            pg8::rss_t* rowss = WSP(pg8::rss_t, WS_ROWSS);
            if (j == 0) { { PHASE_TID();
                pg8::ProbDense<true> S; S.A = WSP(bf16, WS_HB); S.Bt = (const bf16*)(wl + WO_IN); S.K = DM; S.lda = DM; S.ldb = DM; S.bbatch = 0; S.asliced = false; S.ord.init(MTOK / 256, INC / 256, F.G, F.bx, F.vcu);
                pg8::EpiIn E{WSP(bf16, WS_X + X_Q), WSP(bf16, WS_X + X_K), WSP(bf16, WS_X + X_V), WSP(bf16, WS_X + X_BG), WSP(bf16, WS_X + X_U), rowss + (size_t)(3 * l) * MTOK, WSP(float, WS_CS)};
                pg8::gemm_phase<pg8::EpiIn, pg8::ProbDense<true>, true, true>(F.lds + RING_OFF, S, E, F.tid);
                if (l == 0) {
                    pg8::ProbKV S2; S2.A = WSP(bf16, WS_MEMN); S2.Bt0 = WSP(bf16, WS_W + WO_KV); S2.lstride = W_LAYER / 2; S2.K = DM; S2.lda = DM; S2.ldb = DM; S2.G = F.G; S2.c = F.bx;
                    pg8::EpiKV E2{WSP(bf16, WS_KV), KV_LAYER / 2};
                    pg8::gemm_phase<pg8::EpiKV, pg8::ProbKV, true, true>(F.lds + RING_OFF, S2, E2, F.tid);
                }
            } } else if (j == 1) { { PHASE_TID();
                for (int bc = F.vcu; bc < NB * 16; bc += F.G) {
                    const int bhc = bc >> 1, b = bhc >> 3, hc = bhc & 7; const int cqk = hc * 64, cv = (hc >> 1) * 128, co = hc * 128;
                    for (int i = 0; i < 4; ++i) { const int qb = (bc & 1) ? ((0x7421 >> (4 * i)) & 15) : ((0x6530 >> (4 * i)) & 15);
                        attn_body::attn_unit128<8>(b, cqk, cv, co, qb, WSP(const attn_body::bf16, WS_X + X_Q), WSP(const attn_body::bf16, WS_X + X_K), WSP(const attn_body::bf16, WS_X + X_V), WSP(attn_body::bf16, WS_X + X_O), (char*)lds + RING_OFF, F.tid); }
                }
                const bf16* KVl = WSP(bf16, WS_KV) + (size_t)l * (KV_LAYER / 2);
                { pg8::ProbAbsorb S; S.A = KVl; S.Bt = (const bf16*)(wl + WO_QG); S.K = 256; S.lda = 2048; S.ldb = DM; S.a_b = (size_t)256 * 2048; S.a_h = 256; S.a_q = 0; S.b_b = 0; S.b_h = 256; S.b_q = (size_t)256 * DM; S.G = F.G; S.c = F.vcu;
                  pg8::EpiAbsorb E{WSP(bf16, WS_WQK), true};
                  pg8::gemm_phase<pg8::EpiAbsorb, pg8::ProbAbsorb, true, true>(F.lds + RING_OFF, S, E, F.tid); }
                { pg8::ProbAbsorb S; S.A = (const bf16*)(wl + WO_O); S.Bt = KVl + DM; S.K = 256; S.lda = DM; S.ldb = 2048; S.a_b = 0; S.a_h = 256; S.a_q = (size_t)256 * DM; S.b_b = (size_t)256 * 2048; S.b_h = 256; S.b_q = 0; S.G = F.G; S.c = F.vcu;
                  pg8::EpiAbsorb E{WSP(bf16, WS_VWO), false};
                  pg8::gemm_phase<pg8::EpiAbsorb, pg8::ProbAbsorb, true, true>(F.lds + RING_OFF, S, E, F.tid); }
            } } else if (j == 2) { { PHASE_TID();
                const float lambda_init = (l == 0) ? 0.2f : 0.35550906759f;
                const float d1 = wave_sum(INP(5)[l * 64 + F.lane] * INP(6)[l * 64 + F.lane]), d2 = wave_sum(INP(7)[l * 64 + F.lane] * INP(8)[l * 64 + F.lane]);
                const float lam = expf(d1) - expf(d2) + lambda_init;
                const int lane = F.lane, hh = lane >> 4, vhalf = (lane >> 3) & 1, dd = (lane & 7) * 8;
                const int c0col = (hh * 4 + vhalf) * 64 + dd, c1col = (hh * 4 + 2 + vhalf) * 64 + dd;
                const float* subln_g = INP(9); const float* conv_w = INP(10);
                const bf16* XO = WSP(bf16, WS_X + X_O); const bf16* XU = WSP(bf16, WS_X + X_U); const bf16* XBG = WSP(bf16, WS_X + X_BG); bf16* XMIX = WSP(bf16, WS_X + X_MIX);
                float sg[8], cw0[8], cw1[8], cw2[8];
#pragma unroll
                for (int jj = 0; jj < 8; ++jj) { sg[jj] = subln_g[l * 128 + (lane & 15) * 8 + jj] * (1.0f - lambda_init); cw0[jj] = conv_w[(l * 3 + 0) * 512 + lane * 8 + jj]; cw1[jj] = conv_w[(l * 3 + 1) * 512 + lane * 8 + jj]; cw2[jj] = conv_w[(l * 3 + 2) * 512 + lane * 8 + jj]; }
                for (int ch = gw; ch < MTOK / 16; ch += NGW) {
                    const int t0 = ch * 16; float u1[8], u2[8];
                    if ((t0 & (SEQ - 1)) == 0) {
#pragma unroll
                        for (int jj = 0; jj < 8; ++jj) { u1[jj] = 0.f; u2[jj] = 0.f; }
                    } else {
                        const v4u a = *(const v4u*)(XU + pg8::xrow(t0 - 1, 512) + lane * 8), b = *(const v4u*)(XU + pg8::xrow(t0 - 2, 512) + lane * 8);
                        u1[0] = bflo(a.x); u1[1] = bfhi(a.x); u1[2] = bflo(a.y); u1[3] = bfhi(a.y); u1[4] = bflo(a.z); u1[5] = bfhi(a.z); u1[6] = bflo(a.w); u1[7] = bfhi(a.w);
                        u2[0] = bflo(b.x); u2[1] = bfhi(b.x); u2[2] = bflo(b.y); u2[3] = bfhi(b.y); u2[4] = bflo(b.z); u2[5] = bfhi(b.z); u2[6] = bflo(b.w); u2[7] = bfhi(b.w);
                    }
#pragma unroll 4
                    for (int tt = 0; tt < 16; ++tt) { const size_t t5 = pg8::xrow(t0 + tt, 512), t = pg8::xrow(t0 + tt, 1024);
                        const v4u o0 = *(const v4u*)(XO + t + c0col), o1 = *(const v4u*)(XO + t + c1col), uu = *(const v4u*)(XU + t5 + lane * 8), bg = *(const v4u*)(XBG + t5 + lane * 8);
                        float d[8];
                        d[0] = bflo(o0.x) - lam * bflo(o1.x); d[1] = bfhi(o0.x) - lam * bfhi(o1.x); d[2] = bflo(o0.y) - lam * bflo(o1.y); d[3] = bfhi(o0.y) - lam * bfhi(o1.y);
                        d[4] = bflo(o0.z) - lam * bflo(o1.z); d[5] = bfhi(o0.z) - lam * bfhi(o1.z); d[6] = bflo(o0.w) - lam * bflo(o1.w); d[7] = bfhi(o0.w) - lam * bfhi(o1.w);
                        float ss = (d[0] * d[0] + d[1] * d[1]) + (d[2] * d[2] + d[3] * d[3]) + (d[4] * d[4] + d[5] * d[5]) + (d[6] * d[6] + d[7] * d[7]);
                        ss += shx(ss, 1); ss += shx(ss, 2); ss += shx(ss, 4); ss += shx(ss, 8);
                        const float r = __builtin_amdgcn_rsqf(ss * (1.0f / 128.0f) + SUBLN_EPS);
                        v4u oa; oa.x = pk2(d[0] * r * sg[0], d[1] * r * sg[1]); oa.y = pk2(d[2] * r * sg[2], d[3] * r * sg[3]); oa.z = pk2(d[4] * r * sg[4], d[5] * r * sg[5]); oa.w = pk2(d[6] * r * sg[6], d[7] * r * sg[7]);
                        float uc[8], bb[8], y[8];
                        uc[0] = bflo(uu.x); uc[1] = bfhi(uu.x); uc[2] = bflo(uu.y); uc[3] = bfhi(uu.y); uc[4] = bflo(uu.z); uc[5] = bfhi(uu.z); uc[6] = bflo(uu.w); uc[7] = bfhi(uu.w);
                        bb[0] = bflo(bg.x); bb[1] = bfhi(bg.x); bb[2] = bflo(bg.y); bb[3] = bfhi(bg.y); bb[4] = bflo(bg.z); bb[5] = bfhi(bg.z); bb[6] = bflo(bg.w); bb[7] = bfhi(bg.w);
#pragma unroll
                        for (int jj = 0; jj < 8; ++jj) { y[jj] = bb[jj] * (cw0[jj] * u2[jj] + cw1[jj] * u1[jj] + cw2[jj] * uc[jj]); u2[jj] = u1[jj]; u1[jj] = uc[jj]; }
                        v4u oc; oc.x = pk2(y[0], y[1]); oc.y = pk2(y[2], y[3]); oc.z = pk2(y[4], y[5]); oc.w = pk2(y[6], y[7]);
                        *(GAS v4u*)(XMIX + t + lane * 8) = oa; *(GAS v4u*)(XMIX + t + 512 + lane * 8) = oc; }
                }
            } } else if (j == 3) { { PHASE_TID();
                pg8::ProbDense<false> S; S.A = WSP(bf16, WS_X + X_MIX); S.Bt = (const bf16*)(wl + WO_MIX); S.K = DM; S.lda = DM; S.ldb = DM; S.bbatch = 0; S.asliced = true; S.ord.init(MTOK / 256, DM / 256, F.G, F.bx, F.vcu);
                pg8::EpiRes E{args.out, WSP(bf16, WS_HB), rowss + (size_t)(3 * l + 1) * MTOK, (rp == nrep - 1) ? 1.0f : 0.0f, rp == nrep - 1, (PG8_LAS float*)(F.lds + EPIX_OFF)};
                pg8::gemm_phase<pg8::EpiRes, pg8::ProbDense<false>, true, true>(F.lds + RING_OFF, S, E, F.tid);
            } } else if (j == 4) { { PHASE_TID();
                pg8::ProbDense<true> S; S.A = WSP(bf16, WS_HB); S.Bt = WSP(bf16, WS_WQK); S.K = DM; S.lda = DM; S.ldb = DM; S.bbatch = (size_t)DM * DM; S.asliced = false; S.ord.init(MTOK / 256, DM / 256, F.G, F.bx, F.vcu);
                pg8::EpiSoftmax E{WSP(bf16, WS_X + X_P), rowss + (size_t)(3 * l + 1) * MTOK, (PG8_LAS pg8::f32x2*)(F.lds + EPIX_OFF)};
                pg8::gemm_phase<pg8::EpiSoftmax, pg8::ProbDense<true>, true, true>(F.lds + RING_OFF, S, E, F.tid);
            } } else if (j == 5) { { PHASE_TID();
                pg8::ProbDense<true> S; S.A = WSP(bf16, WS_X + X_P); S.Bt = WSP(bf16, WS_VWO); S.K = DM; S.lda = DM; S.ldb = DM; S.bbatch = (size_t)DM * DM; S.asliced = true; S.ord.init(MTOK / 256, DM / 256, F.G, F.bx, F.vcu);
                pg8::EpiRes E{args.out, WSP(bf16, WS_HB), rowss + (size_t)(3 * l + 2) * MTOK, (rp == nrep - 1) ? 1.0f : 0.0f, rp == nrep - 1, (PG8_LAS float*)(F.lds + EPIX_OFF)};
                pg8::gemm_phase<pg8::EpiRes, pg8::ProbDense<true>, true, true>(F.lds + RING_OFF, S, E, F.tid);
            } } else if (j == 6) { { PHASE_TID();
                pg8::ProbDense<true> S; S.A = WSP(bf16, WS_HB); S.Bt = (const bf16*)(wl + WO_1); S.K = DM; S.lda = DM; S.ldb = DM; S.bbatch = 0; S.asliced = false; S.ord.init(MTOK / 256, FF / 256, F.G, F.bx, F.vcu);
                pg8::EpiRelu2 E{WSP(bf16, WS_X + X_F), rowss + (size_t)(3 * l + 2) * MTOK};
                pg8::gemm_phase<pg8::EpiRelu2, pg8::ProbDense<true>, true, true>(F.lds + RING_OFF, S, E, F.tid);
            } } else { { PHASE_TID();
                pg8::ProbDense<true> S; S.A = WSP(bf16, WS_X + X_F); S.Bt = (const bf16*)(wl + WO_2); S.K = FF; S.lda = FF; S.ldb = FF; S.bbatch = 0; S.asliced = true; S.ord.init(MTOK / 256, DM / 256, F.G, F.bx, F.vcu);
                pg8::EpiRes E{args.out, WSP(bf16, WS_HB), rowss + (size_t)(3 * l + 3) * MTOK, (rp == nrep - 1) ? 1.0f : 0.0f, rp == nrep - 1, (PG8_LAS float*)(F.lds + EPIX_OFF)};
                pg8::gemm_phase<pg8::EpiRes, pg8::ProbDense<true>, true, true>(F.lds + RING_OFF, S, E, F.tid);
            } }
        }
      }
        GAS unsigned char* wsb = (GAS unsigned char*)args.ws;
        if (!MK_PER_PHASE && ph0 + 1 < args.ph_hi) { bar.bar = WSP(unsigned, WS_CTL) + CW_BAR; unsigned on2_ = ~0u; asm volatile("" : "+s"(on2_)); const int ln_ = __builtin_amdgcn_mbcnt_hi(on2_, __builtin_amdgcn_mbcnt_lo(on2_, 0u)); const bool leader = (wave0 == 0 && ln_ == 0);
            if (ph0 == 1) {
                if (wave0 == 0) { const int bx_ = blockIdx.x; const unsigned mine = __hip_atomic_load(bar.bar + XB_XID(bx_), RLX_AGENT);
                    const unsigned other = (ln_ < 32) ? __hip_atomic_load(bar.bar + XB_XID((bx_ & 7) + 8 * ln_), RLX_AGENT) : mine;
                    const bool bad = (other != mine) || (mine == 0u) || ((gridDim.x & 7) != 0) || (gridDim.x != 256);
                    if (__any(bad) && ln_ == 0) __hip_atomic_store(bar.bar + XB_BAD, 1u, RLX_AGENT); }
                xcd_barrier(bar, leader);
                local_ok = (__hip_atomic_load(bar.bar + XB_BAD, RLX_AGENT) == 0u);
            } else if (local_ok) {
                const int js_ = (ph0 - 1) % 8; int vc_ = (blockIdx.x % 8) * 32 + blockIdx.x / 8; asm volatile("" : "+s"(vc_));
                if (js_ >= 3) pair_barrier(bar, leader, vc_ >> 1); else xcc_barrier(bar, leader);
            } else xcd_barrier(bar, leader); }
    }
}

extern "C" void kernel_launch(void* const* d_in, const int* in_sizes, int n_in, void* d_out, int out_size, void* d_ws, size_t ws_size, hipStream_t stream) {
    static int grid = 0;
    if (grid == 0) {
        if (n_in != 21 || in_sizes[0] != MTOK * DM || out_size != MTOK * DM || ws_size < WS_END) { fprintf(stderr, "kernel_launch: unexpected shapes (n_in %d, in0 %d, out %d, ws %zu); nothing launched\n", n_in, n_in > 0 ? in_sizes[0] : -1, out_size, ws_size); grid = -1; return; }
        int dev = 0, cus = 0, per_cu = 0;
        if (hipGetDevice(&dev) != hipSuccess || hipDeviceGetAttribute(&cus, hipDeviceAttributeMultiprocessorCount, dev) != hipSuccess) { grid = -1; return; }
        if (hipFuncSetAttribute((const void*)fwd_kernel, hipFuncAttributeMaxDynamicSharedMemorySize, LDS_BYTES) != hipSuccess) { fprintf(stderr, "kernel_launch: hipFuncSetAttribute failed\n"); grid = -1; return; }
        if (hipOccupancyMaxActiveBlocksPerMultiprocessor(&per_cu, (const void*)fwd_kernel, NWAVES * 64, LDS_BYTES) != hipSuccess || per_cu < 1) { fprintf(stderr, "kernel_launch: occupancy query reports %d blocks per CU\n", per_cu); }
        (void)hipGetLastError();
        grid = cus;
    }
    if (grid < 0) return;
    (void)hipMemsetAsync((char*)d_ws + WS_CTL, 0, CTL_ZERO_BYTES, stream);
    Args a{};
    for (int i = 0; i < 21; ++i) a.in[i] = d_in[i];
    a.out = (float*)d_out; a.ws = (unsigned char*)d_ws;
#if MK_PER_PHASE
    for (int p = 0; p < NPH; ++p) { a.ph_lo = p; a.ph_hi = p + 1; a.li = p; hipLaunchKernelGGL(fwd_kernel, dim3(grid), dim3(NWAVES * 64), LDS_BYTES, stream, a); }
#else
    a.ph_lo = 0; a.ph_hi = NPH; a.li = 0;
    hipLaunchKernelGGL(fwd_kernel, dim3(grid), dim3(NWAVES * 64), LDS_BYTES, stream, a);
#endif
}
```

```cpp
#include <hip/hip_runtime.h>
#include <hip/hip_bf16.h>
#include <cstdio>
#include <cstdint>
#include <cmath>

#ifndef RES_F32
#define RES_F32 0
#endif
static_assert(RES_F32 == 0, "the tiled residual layout is implemented for the bf16 residual only");
#ifndef MK_PER_PHASE
#define MK_PER_PHASE 0
#endif

constexpr int NB = 16, SEQ = 2048, DM = 1024, MTOK = NB * SEQ, MEML = 256, MMEM = NB * MEML, INC = 3072, FF = 4096, DEPTH = 2;
constexpr float NORM_EPS = 1e-6f, SUBLN_EPS = 1e-5f;
constexpr float LOG2E = 1.4426950408889634f;
constexpr float C2_ATT = 0.125f * LOG2E;
constexpr float C2_X = 0.0625f * LOG2E;

namespace pg8 {
#define PG8_LAS __attribute__((address_space(3)))
typedef unsigned short bf16_t;
typedef short bf16x8 __attribute__((ext_vector_type(8)));
typedef float f32x4 __attribute__((ext_vector_type(4)));
typedef float f32x2 __attribute__((ext_vector_type(2)));
typedef unsigned u32x4 __attribute__((ext_vector_type(4)));
constexpr int BM = 256, BK = 64, HALF = 128, HTB = HALF * BK * 2, STAGE_BYTES = 8 * HTB, NXCD = 8, WGM = 8;

__host__ __device__ __forceinline__ int lds_byte(int r, int c) { const int st = (r >> 4) * 2 + (c >> 5), rr = r & 15, cc = c & 31, ob = rr * 64 + cc * 2; return st * 1024 + (ob ^ (((ob >> 9) & 1) << 5)); }
__host__ __device__ __forceinline__ void stage_rc(int b, int& R, int& C) { const int st = b / 1024, sb = b % 1024, swz = sb ^ (((sb >> 9) & 1) << 5); R = (st >> 1) * 16 + swz / 64; C = (st & 1) * 32 + (swz % 64) / 2; }
__host__ __device__ __forceinline__ int perm32(int rho) { const int n = rho >> 4, i = rho & 15; return 8 * (i >> 2) + 4 * n + (i & 3); }

__host__ __device__ __forceinline__ int invperm32(int p) { return ((p >> 2) & 1) * 16 + (((p >> 3) << 2) | (p & 3)); }
__host__ __device__ __forceinline__ size_t btile_off(int n, int k, int K) {
    const int nt = n >> 8, half = (n >> 7) & 1, nl = n & 127, R = (nl & ~31) + invperm32(nl & 31), kt = k >> 6, C = k & 63;
    return ((size_t)(nt * (K >> 6) + kt) * 2 + half) * 8192 + (size_t)(lds_byte(R, C) >> 1);
}
__host__ __device__ __forceinline__ size_t atile_off(int r256, int k) { return ((size_t)(k >> 6) * 2 + (r256 >> 7)) * 8192 + (size_t)(lds_byte(r256 & 127, k & 63) >> 1); }
struct Unit { int pm, pn, z; };
typedef __attribute__((address_space(1))) unsigned char gbyte;
struct TileAddr { gbyte* b[2][2]; unsigned voff;
    __device__ __forceinline__ void init(void* panel, int pn, int wr, int wc, int fr, int fq) {
        gbyte* p = (gbyte*)panel + (size_t)__builtin_amdgcn_readfirstlane(pn) * 131072;
        b[0][0] = p; b[1][0] = p + 16384; b[0][1] = p + 65536; b[1][1] = p + 81920;
        asm volatile("" : "+s"(b[0][0]), "+s"(b[1][0]), "+s"(b[0][1]), "+s"(b[1][1]));
        voff = (unsigned)((wc >> 1) * 32768 + lds_byte(wr * 64 + fr, (wc & 1) * 32 + 8 * fq) + 4096); }
    __device__ __forceinline__ __attribute__((address_space(1))) u32x4* at(int ai, int bj, int m) const { return (__attribute__((address_space(1))) u32x4*)(b[ai][bj] + (size_t)voff + (m - 2) * 2048); }
};
constexpr size_t XG_EL = (size_t)16 << 20;
constexpr size_t XP_EL = (size_t)1 << 20;
__device__ __forceinline__ size_t xrow(int row, int ld) { return (size_t)(row >> 8) * XP_EL + (size_t)(row & 255) * ld; }

struct Order2D {
    int nM, nN, nwg, G, c, vcu; bool pair;
    __device__ __forceinline__ void init(int nM_, int nN_, int G_, int c_, int vcu_) { nM = nM_; nN = nN_; nwg = nM * nN; G = G_; c = c_; vcu = vcu_; pair = (G_ == 256) && (nM_ == 128) && ((nN_ & 3) == 0); }
    __device__ __forceinline__ bool next(int i, int& pm, int& pn) const {
        if (pair) { const int per = nN >> 2; if (i >= 2 * per) return false; const int sel = (i >= per) ? 1 : 0; pm = 2 * (vcu >> 2) + sel; pn = 4 * (i - sel * per) + (vcu & 3); return true; }
        const long L = (long)i * G + c; if (L >= nwg) return false;
        int wgid = (int)L; { const int q = nwg / NXCD, r = nwg % NXCD, xcd = wgid % NXCD, off = wgid / NXCD; wgid = (xcd < r ? xcd * (q + 1) : r * (q + 1) + (xcd - r) * q) + off; }
        const int nig = WGM * nN, gid = wgid / nig, fm = gid * WGM, gsz = (nM - fm) < WGM ? (nM - fm) : WGM;
        pm = fm + ((wgid % nig) % gsz); pn = (wgid % nig) / gsz; return true;
    }
};

__device__ __forceinline__ unsigned cvt_pk_bf16(float lo, float hi) { unsigned r; asm volatile("v_cvt_pk_bf16_f32 %0, %1, %2" : "=v"(r) : "v"(lo), "v"(hi)); return r; }

template <class Epi, class Prob, bool ALIGN_EPI, bool SP2>
__device__ __forceinline__ void gemm_phase(PG8_LAS unsigned char* lds, const Prob& S, const Epi& E, const int tid) {
    const int wid = __builtin_amdgcn_readfirstlane(tid >> 6), lane = tid & 63, wr = wid >> 2, wc = wid & 3, fr = lane & 15, fq = lane >> 4;
    const int K = S.K, nt = K / BK;
    unsigned voffA[2], voffB[2];
#pragma unroll
    for (int i = 0; i < 2; ++i) { int R, C; stage_rc(tid * 16 + i * 8192, R, C); const int Rb = (R & ~31) + perm32(R & 31);
        voffA[i] = Prob::ATILED ? (unsigned)(tid * 16 + i * 8192) : (unsigned)(R * S.lda + C) * 2u; voffB[i] = Prob::BTILED ? (unsigned)(tid * 16 + i * 8192) : (unsigned)(Rb * S.ldb + C) * 2u; }
    const size_t kstep = Prob::ATILED ? (size_t)32768 : (size_t)(BK * 2), kstepB = Prob::BTILED ? (size_t)32768 : (size_t)(BK * 2);
    const size_t hstepA = Prob::ATILED ? (size_t)16384 : (size_t)HALF * S.lda * 2, hstepB = Prob::BTILED ? (size_t)16384 : (size_t)HALF * S.ldb * 2;
    const unsigned ldsw = (unsigned)wid * 1024u;
    const int aoff = lds_byte(wr * 64 + fr, fq * 8), boff = lds_byte(wc * 32 + fr, fq * 8);
#define PG8_SA(b, h) (((b) * 2 + (h)) * HTB)
#define PG8_SB(b, h) ((4 + (b) * 2 + (h)) * HTB)
#define PG8_STAGE(bufoff, gbase, voff) do { _Pragma("unroll") for (int _i = 0; _i < 2; ++_i) \
        __builtin_amdgcn_global_load_lds((const unsigned*)((const char*)(gbase) + (voff)[_i]), (PG8_LAS unsigned*)(lds + (bufoff) + ldsw + _i * 8192), 16, 0, 0); } while (0)
#define PG8_LDA(dst, b, h) do { _Pragma("unroll") for (int m = 0; m < 4; ++m) _Pragma("unroll") for (int k = 0; k < 2; ++k) dst[m][k] = *(const PG8_LAS bf16x8*)(lds + PG8_SA(b, h) + aoff + m * 2048 + k * 1024); } while (0)
#define PG8_LDB(dst, b, h) do { _Pragma("unroll") for (int n = 0; n < 2; ++n) _Pragma("unroll") for (int k = 0; k < 2; ++k) dst[n][k] = *(const PG8_LAS bf16x8*)(lds + PG8_SB(b, h) + boff + n * 2048 + k * 1024); } while (0)
#define PG8_MMA(ai, bj, At, Bt) do { __builtin_amdgcn_s_setprio(1); _Pragma("unroll") for (int m = 0; m < 4; ++m) _Pragma("unroll") for (int n = 0; n < 2; ++n) _Pragma("unroll") for (int k = 0; k < 2; ++k) \
        acc[ai][bj][m][n] = __builtin_amdgcn_mfma_f32_16x16x32_bf16(Bt[n][k], At[m][k], acc[ai][bj][m][n], 0, 0, 0); __builtin_amdgcn_s_setprio(0); } while (0)
#define PG8_WAIT_V(n) asm volatile("s_waitcnt vmcnt(" #n ")" ::: "memory")
#define PG8_WAIT_L(n) asm volatile("s_waitcnt lgkmcnt(" #n ")" ::: "memory")
#define PG8_BAR __builtin_amdgcn_s_barrier()
#define PG8_SCHED __builtin_amdgcn_sched_barrier(0)
    Unit cur, nxt; int ui = 0;
    if (!S.next(0, cur)) return;
    typename Epi::Pre pre; E.init(pre); E.prefetch(pre, cur, wr, fr);
    f32x4 acc[2][2][4][2];
#pragma unroll
    for (int a = 0; a < 2; ++a)
#pragma unroll
        for (int b = 0; b < 2; ++b)
#pragma unroll
            for (int m = 0; m < 4; ++m)
#pragma unroll
                for (int n = 0; n < 2; ++n) acc[a][b][m][n] = (f32x4){0.f, 0.f, 0.f, 0.f};
    bf16x8 At[4][2], B0[2][2], B1[2][2];
    const char* cA = S.aptr(cur); const char* cB = S.bptr(cur);
    if constexpr (SP2) {
        PG8_STAGE(PG8_SB(0, 0), cB, voffB); PG8_STAGE(PG8_SB(0, 1), cB + hstepB, voffB); PG8_STAGE(PG8_SA(0, 0), cA, voffA); PG8_STAGE(PG8_SA(0, 1), cA + hstepA, voffA);
        if (wr == 1) PG8_BAR;
        PG8_WAIT_V(2); PG8_BAR;
        PG8_STAGE(PG8_SB(1, 0), cB + kstepB, voffB); PG8_STAGE(PG8_SA(1, 0), cA + kstep, voffA); PG8_STAGE(PG8_SB(1, 1), cB + hstepB + kstepB, voffB);
        PG8_WAIT_V(6); PG8_BAR;
    } else {
        PG8_STAGE(PG8_SB(0, 0), cB, voffB); PG8_STAGE(PG8_SA(0, 0), cA, voffA); PG8_STAGE(PG8_SB(0, 1), cB + hstepB, voffB); PG8_STAGE(PG8_SA(0, 1), cA + hstepA, voffA);
        if (wr == 1) PG8_BAR;
        PG8_WAIT_V(4); PG8_BAR;
        PG8_STAGE(PG8_SB(1, 0), cB + kstepB, voffB); PG8_STAGE(PG8_SA(1, 0), cA + kstep, voffA); PG8_STAGE(PG8_SB(1, 1), cB + hstepB + kstepB, voffB);
        PG8_WAIT_V(6); PG8_BAR;
    }
    for (;;) {
        const bool has_next = S.next(ui + 1, nxt);
        const char* nA = has_next ? S.aptr(nxt) : cA; const char* nB = has_next ? S.bptr(nxt) : cB;
        for (int t = 0; t < nt; t += 2) {
            const bool last = (t == nt - 2);
            const char* a1 = cA + (size_t)(t + 1) * kstep;
            const char* a2 = last ? nA : cA + (size_t)(t + 2) * kstep; const char* b2 = last ? nB : cB + (size_t)(t + 2) * kstepB;
            const char* a3 = a2 + kstep; const char* b3 = b2 + kstepB;
            if constexpr (SP2) {
            PG8_LDB(B0, 0, 0); PG8_LDB(B1, 0, 1); PG8_SCHED; PG8_LDA(At, 0, 0); PG8_STAGE(PG8_SA(1, 1), a1 + hstepA, voffA);
            PG8_WAIT_V(8); PG8_WAIT_L(0); PG8_BAR; PG8_MMA(0, 0, At, B0); PG8_MMA(0, 1, At, B1); PG8_BAR; PG8_SCHED;
            PG8_LDA(At, 0, 1); PG8_STAGE(PG8_SB(0, 0), b2, voffB); PG8_STAGE(PG8_SB(0, 1), b2 + hstepB, voffB); PG8_STAGE(PG8_SA(0, 0), a2, voffA);
            PG8_WAIT_V(8); PG8_WAIT_L(0); PG8_BAR; PG8_MMA(1, 0, At, B0); PG8_MMA(1, 1, At, B1); PG8_BAR; PG8_SCHED;
            PG8_LDB(B0, 1, 0); PG8_LDB(B1, 1, 1); PG8_SCHED; PG8_LDA(At, 1, 0); PG8_STAGE(PG8_SA(0, 1), a2 + hstepA, voffA);
            PG8_WAIT_V(8); PG8_WAIT_L(0); PG8_BAR; PG8_MMA(0, 0, At, B0); PG8_MMA(0, 1, At, B1); PG8_BAR; PG8_SCHED;
            PG8_LDA(At, 1, 1); PG8_STAGE(PG8_SB(1, 0), b3, voffB); PG8_STAGE(PG8_SB(1, 1), b3 + hstepB, voffB); PG8_STAGE(PG8_SA(1, 0), a3, voffA);
            PG8_WAIT_V(8); PG8_WAIT_L(0); PG8_BAR; PG8_MMA(1, 0, At, B0); PG8_MMA(1, 1, At, B1); PG8_BAR; PG8_SCHED;
            } else {
            PG8_LDB(B0, 0, 0); PG8_SCHED; PG8_LDA(At, 0, 0); PG8_STAGE(PG8_SA(1, 1), a1 + hstepA, voffA);
            PG8_WAIT_L(8); PG8_BAR; PG8_WAIT_L(0); PG8_MMA(0, 0, At, B0); PG8_BAR; PG8_SCHED;
            PG8_LDB(B1, 0, 1); PG8_STAGE(PG8_SB(0, 0), b2, voffB);
            PG8_BAR; PG8_WAIT_L(0); PG8_MMA(0, 1, At, B1); PG8_BAR;
            PG8_LDA(At, 0, 1); PG8_STAGE(PG8_SA(0, 0), a2, voffA);
            PG8_BAR; PG8_WAIT_L(0); PG8_MMA(1, 0, At, B0); PG8_BAR; PG8_SCHED;
            PG8_STAGE(PG8_SB(0, 1), b2 + hstepB, voffB);
            PG8_WAIT_V(6); PG8_BAR; PG8_MMA(1, 1, At, B1); PG8_BAR;
            PG8_LDB(B0, 1, 0); PG8_SCHED; PG8_LDA(At, 1, 0); PG8_STAGE(PG8_SA(0, 1), a2 + hstepA, voffA);
            PG8_WAIT_L(8); PG8_BAR; PG8_WAIT_L(0); PG8_MMA(0, 0, At, B0); PG8_BAR; PG8_SCHED;
            PG8_LDB(B1, 1, 1); PG8_STAGE(PG8_SB(1, 0), b3, voffB);
            PG8_BAR; PG8_WAIT_L(0); PG8_MMA(0, 1, At, B1); PG8_BAR;
            PG8_LDA(At, 1, 1); PG8_STAGE(PG8_SA(1, 0), a3, voffA);
            PG8_BAR; PG8_WAIT_L(0); PG8_MMA(1, 0, At, B0); PG8_BAR; PG8_SCHED;
            PG8_STAGE(PG8_SB(1, 1), b3 + hstepB, voffB);
            PG8_WAIT_V(6); PG8_BAR; PG8_MMA(1, 1, At, B1); PG8_BAR;
            }
        }
        if constexpr (ALIGN_EPI) { if (wr == 0) PG8_BAR; }
        { unsigned on_ = ~0u; asm volatile("" : "+s"(on_)); const int ln_ = (int)__builtin_amdgcn_mbcnt_hi(on_, __builtin_amdgcn_mbcnt_lo(on_, 0u)); int fr_ = ln_ & 15, fq_ = ln_ >> 4; asm volatile("" : "+v"(fr_), "+v"(fq_));
          E(acc, cur, wr, wc, fr_, fq_, pre); }
        if (!has_next) break;
#pragma unroll
        for (int a = 0; a < 2; ++a)
#pragma unroll
            for (int b = 0; b < 2; ++b)
#pragma unroll
                for (int m = 0; m < 4; ++m)
#pragma unroll
                    for (int n = 0; n < 2; ++n) acc[a][b][m][n] = (f32x4){0.f, 0.f, 0.f, 0.f};
        cur = nxt; cA = nA; cB = nB; ++ui;
        E.prefetch(pre, cur, wr, fr);
        if constexpr (ALIGN_EPI) { if (wr == 1) PG8_BAR; }
    }
    PG8_WAIT_V(0);
    if constexpr (!ALIGN_EPI) { if (wr == 0) PG8_BAR; }
    PG8_BAR;
    E.finish(pre, wid, lane);
#undef PG8_SA
#undef PG8_SB
#undef PG8_STAGE
#undef PG8_LDA
#undef PG8_LDB
#undef PG8_MMA
#undef PG8_WAIT_V
#undef PG8_WAIT_L
#undef PG8_BAR
#undef PG8_SCHED
}

template <bool ATILED_> struct ProbDense {
    static constexpr bool BTILED = true, ATILED = ATILED_;
    const bf16_t* A; const bf16_t* Bt; int K, lda, ldb; size_t bbatch; Order2D ord; bool asliced;
    __device__ __forceinline__ bool next(int i, Unit& u) const { u.z = 0; return ord.next(i, u.pm, u.pn); }
    __device__ __forceinline__ const char* aptr(const Unit& u) const { return (const char*)(A + (asliced ? xrow(u.pm * BM, lda) : (size_t)u.pm * BM * lda)); }
    __device__ __forceinline__ const char* bptr(const Unit& u) const { return (const char*)(Bt + (size_t)(u.pm >> 3) * bbatch + (size_t)u.pn * BM * ldb); }
};
struct ProbKV {
    static constexpr bool BTILED = true, ATILED = false;
    const bf16_t* A; const bf16_t* Bt0; size_t lstride; int K, lda, ldb; int G, c;
    __device__ __forceinline__ bool next(int i, Unit& u) const { const int L = i * G + c; if (L >= 256) return false; const int g = L & 7, k = L >> 3; u.z = 0; u.pm = 2 * g + (k >> 4); u.pn = k & 15; return true; }
    __device__ __forceinline__ const char* aptr(const Unit& u) const { return (const char*)(A + (size_t)u.pm * BM * lda); }
    __device__ __forceinline__ const char* bptr(const Unit& u) const { return (const char*)(Bt0 + (size_t)(u.pn >> 3) * lstride + (size_t)(u.pn & 7) * BM * ldb); }
};
struct ProbAbsorb {
    static constexpr bool BTILED = false, ATILED = false;
    const bf16_t* A; const bf16_t* Bt; int K, lda, ldb; size_t a_b, a_h, a_q, b_b, b_h, b_q; int G, c;
    __device__ __forceinline__ bool next(int i, Unit& u) const { const int L = i * G + c; if (L >= 256) return false; u.pn = L & 3; u.pm = (L >> 2) & 3; u.z = L >> 4; return true; }
    __device__ __forceinline__ const char* aptr(const Unit& u) const { return (const char*)(A + (size_t)u.z * a_b + (size_t)u.pm * a_h + (size_t)u.pn * a_q); }
    __device__ __forceinline__ const char* bptr(const Unit& u) const { return (const char*)(Bt + (size_t)u.z * b_b + (size_t)u.pm * b_h + (size_t)u.pn * b_q); }
};

__device__ __forceinline__ u32x4 pack8(const f32x4 v0, const f32x4 v1) { u32x4 w; w.x = cvt_pk_bf16(v0[0], v0[1]); w.y = cvt_pk_bf16(v0[2], v0[3]); w.z = cvt_pk_bf16(v1[0], v1[1]); w.w = cvt_pk_bf16(v1[2], v1[3]); return w; }

__device__ __forceinline__ float xor16(float x, bool odd_row) { const unsigned u = __float_as_uint(x); auto r = __builtin_amdgcn_permlane16_swap(u, u, false, false); return __uint_as_float(odd_row ? r[0] : r[1]); }
__device__ __forceinline__ float quad_sum(float x) {
    { const unsigned u = __float_as_uint(x); auto r = __builtin_amdgcn_permlane16_swap(u, u, false, false); x = __uint_as_float(r[0]) + __uint_as_float(r[1]); }
    { const unsigned u = __float_as_uint(x); auto r = __builtin_amdgcn_permlane32_swap(u, u, false, false); x = __uint_as_float(r[0]) + __uint_as_float(r[1]); }
    return x;
}
__device__ __forceinline__ float quad_max(float x) {
    { const unsigned u = __float_as_uint(x); auto r = __builtin_amdgcn_permlane16_swap(u, u, false, false); x = fmaxf(__uint_as_float(r[0]), __uint_as_float(r[1])); }
    { const unsigned u = __float_as_uint(x); auto r = __builtin_amdgcn_permlane32_swap(u, u, false, false); x = fmaxf(__uint_as_float(r[0]), __uint_as_float(r[1])); }
    return x;
}
struct PreNone {};
struct EpiKV {
    bf16_t* O; size_t lstride;
    typedef PreNone Pre; __device__ __forceinline__ void init(Pre&) const {} __device__ __forceinline__ void finish(Pre&, int, int) const {} __device__ __forceinline__ void prefetch(Pre&, const Unit&, int, int) const {}
    __device__ __forceinline__ void operator()(f32x4 (&acc)[2][2][4][2], const Unit& u, int wr, int wc, int fr, int fq, const Pre&) const {
        bf16_t* base = O + (size_t)(u.pn >> 3) * lstride + (size_t)(u.pm * BM + wr * 64 + fr) * 2048 + (u.pn & 7) * BM + wc * 32 + 8 * fq;
#pragma unroll
        for (int ai = 0; ai < 2; ++ai)
#pragma unroll
            for (int m = 0; m < 4; ++m) { bf16_t* rowp = base + (size_t)(ai * HALF + m * 16) * 2048;
#pragma unroll
                for (int bj = 0; bj < 2; ++bj) *(u32x4*)(rowp + bj * HALF) = pack8(acc[ai][bj][m][0], acc[ai][bj][m][1]); }
    }
};
struct EpiAbsorb {
    bf16_t* O; bool rows_by_h;
    typedef PreNone Pre; __device__ __forceinline__ void init(Pre&) const {} __device__ __forceinline__ void finish(Pre&, int, int) const {} __device__ __forceinline__ void prefetch(Pre&, const Unit&, int, int) const {}
    __device__ __forceinline__ void operator()(f32x4 (&acc)[2][2][4][2], const Unit& u, int wr, int wc, int fr, int fq, const Pre&) const {
        bf16_t* base = O + (size_t)u.z * ((size_t)1024 * 1024);
        const int n0 = (rows_by_h ? u.pm : u.pn) * 256 + wr * 64 + fr, k0 = (rows_by_h ? u.pn : u.pm) * 256 + wc * 32 + 8 * fq;
#pragma unroll
        for (int ai = 0; ai < 2; ++ai)
#pragma unroll
            for (int m = 0; m < 4; ++m)
#pragma unroll
                for (int bj = 0; bj < 2; ++bj) *(u32x4*)(base + btile_off(n0 + ai * HALF + m * 16, k0 + bj * HALF, 1024)) = pack8(acc[ai][bj][m][0], acc[ai][bj][m][1]);
    }
};
typedef unsigned long long rss_t;
constexpr float RSS_SCALE = 1048576.0f, RSS_INV = 1.0f / 1048576.0f;
__device__ __forceinline__ float rss_val(const rss_t* rowss, int row) { const rss_t v = rowss[row]; return ((float)(unsigned)(v >> 32) * 4096.0f + (float)(unsigned)v * RSS_INV); }
__device__ __forceinline__ rss_t rss_fix(float ss) { return (rss_t)(ss * RSS_SCALE + 0.5f); }
__device__ __forceinline__ float rstd_of(const rss_t* rowss, int row) { return __builtin_amdgcn_rsqf(rss_val(rowss, row) * (1.0f / 1024.0f) + NORM_EPS); }

struct PreRss { rss_t v[2][4]; };
__device__ __forceinline__ void rss_prefetch(PreRss& p, const rss_t* rowss, int row0) {
#pragma unroll
    for (int ai = 0; ai < 2; ++ai)
#pragma unroll
        for (int m = 0; m < 4; ++m) p.v[ai][m] = rowss[row0 + ai * HALF + m * 16];
}
__device__ __forceinline__ void rstd8(float (&r)[2][4], const PreRss& p, float sc) {
    const rss_t (&v)[2][4] = p.v;
#pragma unroll
    for (int ai = 0; ai < 2; ++ai)
#pragma unroll
        for (int m = 0; m < 4; ++m) r[ai][m] = __builtin_amdgcn_rsqf(((float)(unsigned)(v[ai][m] >> 32) * 4096.0f + (float)(unsigned)v[ai][m] * RSS_INV) * (1.0f / 1024.0f) + NORM_EPS) * sc;
}
struct EpiIn {
    bf16_t *Q, *Kb, *V, *Bg, *U; const rss_t* rowss; const float* cs;
    typedef PreRss Pre; __device__ __forceinline__ void init(Pre&) const {} __device__ __forceinline__ void finish(Pre&, int, int) const {} __device__ __forceinline__ void prefetch(Pre& p, const Unit& u, int wr, int fr) const { rss_prefetch(p, rowss, u.pm * BM + wr * 64 + fr); }
    __device__ __forceinline__ void operator()(f32x4 (&acc)[2][2][4][2], const Unit& u, int wr, int wc, int fr, int fq, const Pre& pre) const {
        const int pn = u.pn; const int row0 = u.pm * BM + wr * 64 + fr, colw = wc * 32 + 8 * fq;
        float r[2][4];
        if (pn < 4) {
            bf16_t* dst = (pn < 2 ? Q : Kb) + xrow(row0, 512) + (pn & 1) * 256 + colw;
            rstd8(r, pre, pn < 2 ? C2_ATT : 1.0f);
            const bool rotw = (wc & 1) == 0; const float sgn = fq == 0 ? -1.0f : 1.0f; const bool rotl = fq < 2;
            if (rotw) {
                const f32x4* cp = (const f32x4*)(cs + (size_t)row0 * 16); f32x4 nc0 = cp[0], nc1 = cp[1], ns0 = cp[2], ns1 = cp[3];
#pragma unroll
                for (int i = 0; i < 8; ++i) { const int ai = i >> 2, m = i & 3; const f32x4 c0 = nc0, c1 = nc1, s0 = ns0, s1 = ns1;
                    if (i < 7) { const int i2 = i + 1; const f32x4* cq = (const f32x4*)(cs + (size_t)(row0 + (i2 >> 2) * HALF + (i2 & 3) * 16) * 16); nc0 = cq[0]; nc1 = cq[1]; ns0 = cq[2]; ns1 = cq[3]; }
#pragma unroll
                    for (int bj = 0; bj < 2; ++bj) { f32x4 v0 = acc[ai][bj][m][0] * r[ai][m], v1 = acc[ai][bj][m][1] * r[ai][m], o0, o1;
#pragma unroll
                        for (int j = 0; j < 4; ++j) { o0[j] = xor16(v0[j], (fq & 1) != 0); o1[j] = xor16(v1[j], (fq & 1) != 0); }
                        if (rotl) { v0 = v0 * c0 + o0 * s0 * sgn; v1 = v1 * c1 + o1 * s1 * sgn; }
                        *(u32x4*)(dst + (size_t)(ai * HALF + m * 16) * 512 + bj * HALF) = pack8(v0, v1); }
                    asm volatile("" ::: "memory"); }
            } else {
#pragma unroll
                for (int ai = 0; ai < 2; ++ai)
#pragma unroll
                    for (int m = 0; m < 4; ++m)
#pragma unroll
                        for (int bj = 0; bj < 2; ++bj) *(u32x4*)(dst + (size_t)(ai * HALF + m * 16) * 512 + bj * HALF) = pack8(acc[ai][bj][m][0] * r[ai][m], acc[ai][bj][m][1] * r[ai][m]);
            }
        } else if (pn < 8) {
            bf16_t* dst = (pn < 6 ? V : Bg) + xrow(row0, 512) + (pn & 1) * 256 + colw;
            rstd8(r, pre, 1.0f);
#pragma unroll
            for (int ai = 0; ai < 2; ++ai)
#pragma unroll
                for (int m = 0; m < 4; ++m)
#pragma unroll
                    for (int bj = 0; bj < 2; ++bj) *(u32x4*)(dst + (size_t)(ai * HALF + m * 16) * 512 + bj * HALF) = pack8(acc[ai][bj][m][0] * r[ai][m], acc[ai][bj][m][1] * r[ai][m]);
        } else {
            bf16_t* dst = U + xrow(row0, 512) + (pn - 8) * 128 + colw;
            rstd8(r, pre, 1.0f);
#pragma unroll
            for (int ai = 0; ai < 2; ++ai)
#pragma unroll
                for (int m = 0; m < 4; ++m) { const float r2 = r[ai][m] * r[ai][m];
                    *(u32x4*)(dst + (size_t)(ai * HALF + m * 16) * 512) = pack8(acc[ai][0][m][0] * acc[ai][1][m][0] * r2, acc[ai][0][m][1] * acc[ai][1][m][1] * r2); }
        }
    }
};
struct EpiRes {
    float* H32; bf16_t* HB; rss_t* rowss_out; float scale; bool do_ss; PG8_LAS float* X;
    struct Pre { int prev_pm, buf; };
    __device__ __forceinline__ void init(Pre& p) const { p.prev_pm = -1; p.buf = 0; }
    __device__ __forceinline__ void prefetch(Pre&, const Unit&, int, int) const {}
    __device__ __forceinline__ void flush(int pm, int bufsel, int wv, int ln) const {
        if (ln < 32 && do_ss) { const int rl = wv * 32 + ln; const f32x4 p4 = *(const PG8_LAS f32x4*)(X + bufsel * 1024 + rl * 4);
            atomicAdd(rowss_out + pm * BM + rl, rss_fix((p4[0] + p4[1]) + (p4[2] + p4[3]))); } }
    __device__ __forceinline__ void finish(Pre& p, int wv, int ln) const { if (p.prev_pm >= 0) flush(p.prev_pm, p.buf ^ 1, wv, ln); }
    __device__ __forceinline__ void operator()(f32x4 (&acc)[2][2][4][2], const Unit& u, int wr, int wc, int fr, int fq, Pre& pst) const {
        const int row0 = u.pm * BM + wr * 64 + fr, col0 = u.pn * BM + wc * 32 + 8 * fq;
#if RES_F32
#pragma unroll
        for (int ai = 0; ai < 2; ++ai)
#pragma unroll
            for (int m = 0; m < 4; ++m) { const int row = row0 + ai * HALF + m * 16; float ss = 0.f;
#pragma unroll
                for (int bj = 0; bj < 2; ++bj) { const size_t off = (size_t)row * 1024 + col0 + bj * HALF; f32x4 v0, v1;
                    v0 = *(const f32x4*)(H32 + off); v1 = *(const f32x4*)(H32 + off + 4);
                    v0 = v0 + acc[ai][bj][m][0] * scale; v1 = v1 + acc[ai][bj][m][1] * scale;
                    *(f32x4*)(H32 + off) = v0; *(f32x4*)(H32 + off + 4) = v1;
                    *(u32x4*)(HB + off) = pack8(v0, v1);
                    ss += (v0[0] * v0[0] + v0[1] * v0[1]) + (v0[2] * v0[2] + v0[3] * v0[3]) + (v1[0] * v1[0] + v1[1] * v1[1]) + (v1[2] * v1[2] + v1[3] * v1[3]); }
                ss = quad_sum(ss);
                if (fq == 0 && do_ss) atomicAdd(rowss_out + row, rss_fix(ss));
                if (m & 1) asm volatile("" ::: "memory"); }
#else
        TileAddr ta; ta.init(HB + (size_t)__builtin_amdgcn_readfirstlane(u.pm) * (BM * 1024), u.pn, wr, wc, fr, fq);
#define HBP(ai_, bj_, m_) ta.at(ai_, bj_, m_)
        u32x4 old[8][2];
#pragma unroll
        for (int i = 0; i < 8; ++i) { old[i][0] = *HBP(i >> 2, 0, i & 3); old[i][1] = *HBP(i >> 2, 1, i & 3); }
#pragma unroll
        for (int i = 0; i < 8; ++i) { const int ai = i >> 2, m = i & 3;
            f32x2 s2 = (f32x2){0.f, 0.f};
#pragma unroll
            for (int bj = 0; bj < 2; ++bj) { const u32x4 hw = old[i][bj];
                f32x4 v0 = (f32x4){__uint_as_float(hw.x << 16), __uint_as_float(hw.x & 0xffff0000u), __uint_as_float(hw.y << 16), __uint_as_float(hw.y & 0xffff0000u)};
                f32x4 v1 = (f32x4){__uint_as_float(hw.z << 16), __uint_as_float(hw.z & 0xffff0000u), __uint_as_float(hw.w << 16), __uint_as_float(hw.w & 0xffff0000u)};
                v0 = v0 + acc[ai][bj][m][0] * scale; v1 = v1 + acc[ai][bj][m][1] * scale;
                *HBP(ai, bj, m) = pack8(v0, v1);
                const f32x2 p0 = (f32x2){v0[0], v0[1]}, p1 = (f32x2){v0[2], v0[3]}, p2 = (f32x2){v1[0], v1[1]}, p3 = (f32x2){v1[2], v1[3]};
                s2 = s2 + p0 * p0; s2 = s2 + p1 * p1; s2 = s2 + p2 * p2; s2 = s2 + p3 * p3; }
            float ss = s2[0] + s2[1];
            ss = quad_sum(ss);
            if (fq == 0) X[pst.buf * 1024 + (ai * HALF + wr * 64 + m * 16 + fr) * 4 + wc] = ss; }
        { const int wv = wr * 4 + wc; int ln = fq * 16 + fr; asm volatile("" : "+v"(ln));
          if (pst.prev_pm >= 0) flush(pst.prev_pm, pst.buf ^ 1, wv, ln);
          pst.prev_pm = u.pm; pst.buf ^= 1; }
        asm volatile("s_waitcnt lgkmcnt(0)" ::: "memory");
#undef HBP
#endif
    }
};
struct EpiSoftmax {
    bf16_t* P; const rss_t* rowss; PG8_LAS f32x2* X;
    typedef PreRss Pre; __device__ __forceinline__ void init(Pre&) const {} __device__ __forceinline__ void finish(Pre&, int, int) const {} __device__ __forceinline__ void prefetch(Pre& p, const Unit& u, int wr, int fr) const { rss_prefetch(p, rowss, u.pm * BM + wr * 64 + fr); }
    __device__ __forceinline__ void operator()(f32x4 (&acc)[2][2][4][2], const Unit& u, int wr, int wc, int fr, int fq, const Pre& pre) const {
        const int row0 = u.pm * BM + wr * 64 + fr, col0 = u.pn * BM + wc * 32 + 8 * fq;
        float mown[2][4], rr[2][4]; rstd8(rr, pre, C2_X);
#pragma unroll
        for (int ai = 0; ai < 2; ++ai)
#pragma unroll
            for (int m = 0; m < 4; ++m) { const float r = rr[ai][m]; float mx = -INFINITY;
#pragma unroll
                for (int bj = 0; bj < 2; ++bj)
#pragma unroll
                    for (int n = 0; n < 2; ++n) { f32x4 s = acc[ai][bj][m][n] * r; acc[ai][bj][m][n] = s; mx = fmaxf(mx, fmaxf(fmaxf(s[0], s[1]), fmaxf(s[2], s[3]))); }
                mx = quad_max(mx); float l = 0.f;
#pragma unroll
                for (int bj = 0; bj < 2; ++bj)
#pragma unroll
                    for (int n = 0; n < 2; ++n) { f32x4 s = acc[ai][bj][m][n]; f32x4 e;
#pragma unroll
                        for (int j = 0; j < 4; ++j) e[j] = __builtin_amdgcn_exp2f(s[j] - mx);
                        acc[ai][bj][m][n] = e; l += (e[0] + e[1]) + (e[2] + e[3]); }
                l = quad_sum(l);
                mown[ai][m] = mx;
                if (fq == 0) X[(ai * HALF + wr * 64 + m * 16 + fr) * 4 + wc] = (f32x2){mx, l}; }
        asm volatile("s_waitcnt lgkmcnt(0)" ::: "memory"); __builtin_amdgcn_s_barrier(); asm volatile("" ::: "memory");
        TileAddr ta; ta.init(P + xrow(__builtin_amdgcn_readfirstlane(u.pm) * BM, 1024), u.pn, wr, wc, fr, fq);
#pragma unroll
        for (int ai = 0; ai < 2; ++ai)
#pragma unroll
            for (int m = 0; m < 4; ++m) { const int rl = ai * HALF + wr * 64 + m * 16 + fr;
                const f32x2 a = X[rl * 4 + 0], b = X[rl * 4 + 1], c = X[rl * 4 + 2], d = X[rl * 4 + 3];
                const float M = fmaxf(fmaxf(a.x, b.x), fmaxf(c.x, d.x));
                const float L = (a.y * __builtin_amdgcn_exp2f(a.x - M) + b.y * __builtin_amdgcn_exp2f(b.x - M)) + (c.y * __builtin_amdgcn_exp2f(c.x - M) + d.y * __builtin_amdgcn_exp2f(d.x - M));
                const float f = __builtin_amdgcn_exp2f(mown[ai][m] - M) / L;
#pragma unroll
                for (int bj = 0; bj < 2; ++bj) *ta.at(ai, bj, m) = pack8(acc[ai][bj][m][0] * f, acc[ai][bj][m][1] * f); }
    }
};
struct EpiRelu2 {
    bf16_t* F; const rss_t* rowss;
    typedef PreRss Pre; __device__ __forceinline__ void init(Pre&) const {} __device__ __forceinline__ void finish(Pre&, int, int) const {} __device__ __forceinline__ void prefetch(Pre& p, const Unit& u, int wr, int fr) const { rss_prefetch(p, rowss, u.pm * BM + wr * 64 + fr); }
    __device__ __forceinline__ void operator()(f32x4 (&acc)[2][2][4][2], const Unit& u, int wr, int wc, int fr, int fq, const Pre& pre) const {
        const int row0 = u.pm * BM + wr * 64 + fr, col0 = u.pn * BM + wc * 32 + 8 * fq;
        float rr[2][4]; rstd8(rr, pre, 1.0f);
        TileAddr ta; ta.init(F + xrow(__builtin_amdgcn_readfirstlane(u.pm) * BM, FF), u.pn, wr, wc, fr, fq);
#pragma unroll
        for (int ai = 0; ai < 2; ++ai)
#pragma unroll
            for (int m = 0; m < 4; ++m) { const float r = rr[ai][m];
#pragma unroll
                for (int bj = 0; bj < 2; ++bj) { f32x4 v0 = acc[ai][bj][m][0] * r, v1 = acc[ai][bj][m][1] * r;
                    f32x2 q0 = (f32x2){fmaxf(v0[0], 0.f), fmaxf(v0[1], 0.f)}, q1 = (f32x2){fmaxf(v0[2], 0.f), fmaxf(v0[3], 0.f)}, q2 = (f32x2){fmaxf(v1[0], 0.f), fmaxf(v1[1], 0.f)}, q3 = (f32x2){fmaxf(v1[2], 0.f), fmaxf(v1[3], 0.f)};
                    q0 = q0 * q0; q1 = q1 * q1; q2 = q2 * q2; q3 = q3 * q3;
                    u32x4 w; w.x = cvt_pk_bf16(q0[0], q0[1]); w.y = cvt_pk_bf16(q1[0], q1[1]); w.z = cvt_pk_bf16(q2[0], q2[1]); w.w = cvt_pk_bf16(q3[0], q3[1]);
                    *ta.at(ai, bj, m) = w; } }
    }
};
}

namespace attn_body {
using bf16=__hip_bfloat16;
using bf16x8=__attribute__((ext_vector_type(8)))short;
using s16x4=__attribute__((ext_vector_type(4)))short;
using f32x16=__attribute__((ext_vector_type(16)))float;
using u32x4=__attribute__((ext_vector_type(4)))unsigned;
constexpr int SEQL=2048,D=64,PQ=512,PO=1024;
constexpr int NW=8,QBLK=32,QB=QBLK*NW,KVBLK=64,NQB=SEQL/QB;
__device__ __forceinline__ int crow(int r,int hi){return (r&3)+8*(r>>2)+4*hi;}
#define SBAR() __builtin_amdgcn_sched_barrier(0)
__device__ __forceinline__ void cmask(f32x16&p0,f32x16&p1,int jb,int qrel,int hi){
  const float NEG=-INFINITY; int kb=64*jb+4*hi;
  #pragma unroll
  for(int r=0;r<16;++r){int kv=kb+(r&3)+8*(r>>2); if(kv>qrel)p0[r]=NEG; if(kv+32>qrel)p1[r]=NEG;}
}
constexpr int NSLOT=3, SLOTB=8192;
constexpr int LDS_K=0, LDS_V=NSLOT*SLOTB, LDS_WS=2*NSLOT*SLOTB, LDS_OST=LDS_WS+NW*64*4, LDS_BYTES=LDS_OST+NW*4096;
__device__ __forceinline__ void glds16(const void*gsrc,unsigned lds_dst){unsigned keep;
  asm volatile("s_mov_b32 %0, m0\n\ts_mov_b32 m0, %2\n\ts_nop 0\n\tglobal_load_lds_dwordx4 %1, off\n\ts_mov_b32 m0, %0":"=&s"(keep):"v"(gsrc),"s"(lds_dst):"memory");}
__device__ __forceinline__ float max3f(float a,float b,float c){float r;asm("v_max3_f32 %0, %1, %2, %3":"=v"(r):"v"(a),"v"(b),"v"(c));return r;}
__device__ __forceinline__ float max2f(float a,float b){float r;asm("v_max_f32_e32 %0, %1, %2":"=v"(r):"v"(a),"v"(b));return r;}
__device__ __forceinline__ float fadd_s(float a,float b){float r;asm("v_add_f32_e32 %0, %1, %2":"=v"(r):"v"(a),"v"(b));return r;}
__device__ __forceinline__ float fsub_s(float a,float b){float r;asm("v_sub_f32_e32 %0, %1, %2":"=v"(r):"v"(a),"v"(b));return r;}
typedef float f32x2_t __attribute__((ext_vector_type(2))); typedef __bf16 bf16x2_t __attribute__((ext_vector_type(2)));
__device__ __forceinline__ unsigned cvtpk_s(float lo,float hi){f32x2_t v={lo,hi};bf16x2_t b=__builtin_convertvector(v,bf16x2_t);return __builtin_bit_cast(unsigned,b);}
#define WAIT_BAR(N) asm volatile("s_waitcnt vmcnt(" #N ") lgkmcnt(0)\n\ts_barrier":::"memory")

__device__ __forceinline__ void qkt(f32x16&p0,f32x16&p1,const char*Kslot,const bf16x8*qr,const f32x16&negm,int r32,int hi){
  const char*kb=Kslot+hi*1024+r32*16;
  #pragma unroll
  for(int d0=0;d0<4;++d0){
    const bf16x8 b0=*reinterpret_cast<const bf16x8*>(kb+d0*2048);
    const bf16x8 b1=*reinterpret_cast<const bf16x8*>(kb+d0*2048+512);
    if(d0==0){p0=__builtin_amdgcn_mfma_f32_32x32x16_bf16(b0,qr[0],negm,0,0,0);p1=__builtin_amdgcn_mfma_f32_32x32x16_bf16(b1,qr[0],negm,0,0,0);}
    else{p0=__builtin_amdgcn_mfma_f32_32x32x16_bf16(b0,qr[d0],p0,0,0,0);p1=__builtin_amdgcn_mfma_f32_32x32x16_bf16(b1,qr[d0],p1,0,0,0);}}
}
typedef __attribute__((address_space(3))) const char* lds_cptr;
typedef short v4i16_t __attribute__((ext_vector_type(4)));
__device__ __forceinline__ void kload8(bf16x8*kf,lds_cptr kp){
  kf[0]=*(const __attribute__((address_space(3))) bf16x8*)(kp);      kf[1]=*(const __attribute__((address_space(3))) bf16x8*)(kp+512);
  kf[2]=*(const __attribute__((address_space(3))) bf16x8*)(kp+2048); kf[3]=*(const __attribute__((address_space(3))) bf16x8*)(kp+2560);
  kf[4]=*(const __attribute__((address_space(3))) bf16x8*)(kp+4096); kf[5]=*(const __attribute__((address_space(3))) bf16x8*)(kp+4608);
  kf[6]=*(const __attribute__((address_space(3))) bf16x8*)(kp+6144); kf[7]=*(const __attribute__((address_space(3))) bf16x8*)(kp+6656);
}
__device__ __forceinline__ void kload2(bf16x8*kf,lds_cptr kp,int j){ kf[2*j]=*(const __attribute__((address_space(3))) bf16x8*)(kp+j*2048); kf[2*j+1]=*(const __attribute__((address_space(3))) bf16x8*)(kp+j*2048+512); }
__device__ __forceinline__ s16x4 vtr(lds_cptr p){ return __builtin_bit_cast(s16x4,__builtin_amdgcn_ds_read_tr16_b64_v4i16((__attribute__((address_space(3))) v4i16_t*)p)); }
__device__ __forceinline__ float rowmax(const f32x16&p0,const f32x16&p1){
  float a=max3f(p0[0],p0[1],p1[0]),b=max3f(p0[2],p0[3],p1[1]);a=max3f(a,p1[2],p1[3]);
  #pragma unroll
  for(int r=4;r<16;r+=4){a=max3f(a,p0[r],p0[r+1]);b=max3f(b,p0[r+2],p0[r+3]);a=max3f(a,p1[r],p1[r+1]);b=max3f(b,p1[r+2],p1[r+3]);}
  const float m=max2f(a,b);
  auto rr=__builtin_amdgcn_permlane32_swap(__float_as_uint(m),__float_as_uint(m),false,false);
  return max2f(__uint_as_float(rr[0]),__uint_as_float(rr[1]));
}
__device__ __forceinline__ void pv(f32x16*o,int vb,bf16x8 pa0,bf16x8 pa1,bf16x8 pa2,bf16x8 pa3){
  #pragma unroll
  for(int d0=0;d0<2;++d0){s16x4 lo[4],hi[4];
    #pragma unroll
    for(int ks=0;ks<4;++ks){
      asm volatile("ds_read_b64_tr_b16 %0,%1 offset:%c2":"=&v"(lo[ks]):"v"(vb),"i"(d0*4096+ks*1024):"memory");
      asm volatile("ds_read_b64_tr_b16 %0,%1 offset:%c2":"=&v"(hi[ks]):"v"(vb),"i"(d0*4096+ks*1024+512):"memory");}
    asm volatile("s_waitcnt lgkmcnt(0)":::"memory");SBAR();
    #define PK(k) (bf16x8){lo[k][0],lo[k][1],lo[k][2],lo[k][3],hi[k][0],hi[k][1],hi[k][2],hi[k][3]}
    o[d0]=__builtin_amdgcn_mfma_f32_32x32x16_bf16(pa0,PK(0),o[d0],0,0,0);
    o[d0]=__builtin_amdgcn_mfma_f32_32x32x16_bf16(pa1,PK(1),o[d0],0,0,0);
    o[d0]=__builtin_amdgcn_mfma_f32_32x32x16_bf16(pa2,PK(2),o[d0],0,0,0);
    o[d0]=__builtin_amdgcn_mfma_f32_32x32x16_bf16(pa3,PK(3),o[d0],0,0,0);
    #undef PK
  }
}
#define ATTN_STORE16(p,v) (*(u32x4*)(p)=(v))
template<int THRL> __device__ __forceinline__ void attn_unit(int b,int cqk,int cv,int co,int qb,const bf16*Q,const bf16*__restrict__ K,const bf16*__restrict__ V,bf16*O,char*shm,const int tid_in){
  int tid=tid_in; asm volatile("":"+v"(tid));
  const int lane=tid&63,r32=lane&31,hi=lane>>5; const int wid=__builtin_amdgcn_readfirstlane(tid>>6);
  const long rowbase=(long)b*SEQL; const int q0=qb*QB;
  const bf16*Qw=Q+(rowbase+q0+wid*QBLK)*PQ+cqk;
  const bf16*Kh=K+rowbase*PQ+cqk,*Vh=V+rowbase*PQ+cv;
  const unsigned lds0=(unsigned)(uintptr_t)shm;
  float*wsf=(float*)(shm+LDS_WS)+wid*64;
  const bf16*ksrc=Kh+(long)lane*PQ+wid*8;
  const bf16*vsrc=Vh+(long)(16*(wid&3)+(lane>>2))*PQ+(wid>>2)*32+(lane&3)*8;
  const unsigned kdst=lds0+LDS_K+wid*1024, vdst=lds0+LDS_V+wid*1024;
  #define DMA_K(t,slot) glds16(ksrc+(long)(t)*KVBLK*PQ,(unsigned)__builtin_amdgcn_readfirstlane(kdst+(slot)))
  #define DMA_V(t,slot) glds16(vsrc+(long)(t)*KVBLK*PQ,(unsigned)__builtin_amdgcn_readfirstlane(vdst+(slot)))
  const int vb0=(int)(lds0+LDS_V)+((lane>>4)&1)*32+(lane&3)*8+(4*hi+((lane&15)>>2))*64;
  const char*Kbase=shm+LDS_K; bf16x8 kf[8];
  const lds_cptr shm3=(lds_cptr)shm; const lds_cptr kp0=shm3+LDS_K+hi*1024+r32*16; const lds_cptr vp0=shm3+LDS_V+((lane>>4)&1)*32+(lane&3)*8+(4*hi+((lane&15)>>2))*64;
  const int NT=(q0+QB)/KVBLK;
  DMA_K(0,0);DMA_V(0,0);DMA_K(1,SLOTB);
  bf16x8 qr[4];
  #pragma unroll
  for(int d0=0;d0<4;++d0)qr[d0]=*reinterpret_cast<const bf16x8*>(&Qw[(long)r32*PQ+d0*16+hi*8]);
  float zz_=0.f;asm volatile("":"+v"(zz_));float mhat=zz_,l_reg=zz_;f32x16 o[2];f32x16 negm;
  _Pragma("unroll") for(int r=0;r<16;++r){o[0][r]=zz_;o[1][r]=zz_;negm[r]=zz_;} asm volatile("":"+v"(negm));
  const int qrel=wid*QBLK+r32;
  #define CMASK(P0,P1,t) do{int jb_=(t)-(NT-4); if(jb_>=0)cmask(P0,P1,jb_,qrel,hi);}while(0)
  bool resc=false;
  #define START(P0,P1) do{ const float rm=rowmax(P0,P1); resc=false; \
    { const float dl=rm; mhat=fadd_s(mhat,dl); \
      _Pragma("unroll") for(int r=0;r<16;++r){P0[r]=fsub_s(P0[r],dl);P1[r]=fsub_s(P1[r],dl);} \
      _Pragma("unroll") for(int r=0;r<16;++r)negm[r]=-mhat; asm volatile("":"+v"(negm)); } \
    _Pragma("unroll") for(int r=0;r<16;++r)P0[r]=__builtin_amdgcn_exp2f(P0[r]); }while(0)
  #define RESC() do{ if(resc){ asm volatile("s_waitcnt lgkmcnt(0)":::"memory"); \
      _Pragma("unroll") for(int d_=0;d_<2;++d_) _Pragma("unroll") for(int r=0;r<16;++r)o[d_][r]*=wsf[crow(r,hi)]; } }while(0)
  f32x16 pA0,pA1,pB0,pB1;
  int sl_prev=0,sl_cur=0,sl_next=SLOTB;
  #define ROT() do{sl_prev=sl_cur;sl_cur=sl_next;sl_next=(sl_next==(NSLOT-1)*SLOTB)?0:sl_next+SLOTB;}while(0)
  DMA_K(2,2*SLOTB);
  WAIT_BAR(3);
  qkt(pA0,pA1,Kbase,qr,negm,r32,hi);asm volatile("s_nop 15\n\ts_nop 7":"+v"(pA0),"+v"(pA1));CMASK(pA0,pA1,0);
  START(pA0,pA1);
  _Pragma("unroll") for(int r=0;r<16;++r)pA1[r]=__builtin_amdgcn_exp2f(pA1[r]);
  WAIT_BAR(0);
  DMA_K(3,0);DMA_V(1,SLOTB);
  ROT();
  kload8(kf,kp0+sl_cur);
  WAIT_BAR(2);
  s16x4 vlo[8],vhi[8]; u32x4 pw0,pw1,pw2,pw3;
  #define PKW(P,B) cvtpk_s(P[B],P[B+1])
  #define PAF(k) __builtin_bit_cast(bf16x8,pw##k)
  #define VFR(i) (bf16x8){vlo[i][0],vlo[i][1],vlo[i][2],vlo[i][3],vhi[i][0],vhi[i][1],vhi[i][2],vhi[i][3]}
  #define PIN(x) asm volatile("":"+v"(x))
  #define MX3(a,b,c) __builtin_fmaxf(__builtin_fmaxf((a),(b)),(c))
  #define GAPA(MF,A0,A1,A2,A3,W0,W1,PW) do{ MF; sacc+=A0; sacc+=A1; sacc+=A2; sacc+=A3; PIN(sacc); W0; W1; PIN(PW); SBAR(); }while(0)
  #define EX(v) __builtin_amdgcn_exp2f(v)
  #define GAPB(MF,X,B) do{ MF; X[B]=EX(X[B]); X[B+1]=EX(X[B+1]); X[B+2]=EX(X[B+2]); X[B+3]=EX(X[B+3]); PIN(X); SBAR(); }while(0)
  #define VRD(i) do{ vlo[i]=vtr(vp_+(((i)>>2)*4096+((i)&3)*1024)); vhi[i]=vtr(vp_+(((i)>>2)*4096+((i)&3)*1024+512)); }while(0)
  #define KRD(G,j) do{ if(G){ kload2(kf,kp0+sl_next,j); SBAR(); } }while(0)
  #define STEP(C0,C1,P0,P1,t,GK,GV,GL) do{ SBAR(); \
    const lds_cptr vp_=vp0+sl_prev; \
    VRD(0); SBAR(); float sacc=(P0[0]+P0[1]); \
    GAPA(C0=__builtin_amdgcn_mfma_f32_32x32x16_bf16(kf[0],qr[0],negm,0,0,0), P0[2],P0[3],P0[4],P0[5],     pw0[0]=PKW(P0,0), pw0[1]=PKW(P0,2), pw0); \
    VRD(4); SBAR(); GAPA(C1=__builtin_amdgcn_mfma_f32_32x32x16_bf16(kf[1],qr[0],negm,0,0,0), P0[6],P0[7],P0[8],P0[9],     pw0[2]=PKW(P0,4), pw0[3]=PKW(P0,6), pw0); \
    VRD(1); SBAR(); GAPA(C0=__builtin_amdgcn_mfma_f32_32x32x16_bf16(kf[2],qr[1],C0,0,0,0),   P0[10],P0[11],P0[12],P0[13], pw1[0]=PKW(P0,8), pw1[1]=PKW(P0,10), pw1); \
    VRD(5); SBAR(); GAPA(C1=__builtin_amdgcn_mfma_f32_32x32x16_bf16(kf[3],qr[1],C1,0,0,0),   P0[14],P0[15],P1[0],P1[1],   pw1[2]=PKW(P0,12),pw1[3]=PKW(P0,14), pw1); \
    VRD(2); SBAR(); GAPA(C0=__builtin_amdgcn_mfma_f32_32x32x16_bf16(kf[4],qr[2],C0,0,0,0),   P1[2],P1[3],P1[4],P1[5],     pw2[0]=PKW(P1,0), pw2[1]=PKW(P1,2), pw2); \
    VRD(6); SBAR(); GAPA(C1=__builtin_amdgcn_mfma_f32_32x32x16_bf16(kf[5],qr[2],C1,0,0,0),   P1[6],P1[7],P1[8],P1[9],     pw2[2]=PKW(P1,4), pw2[3]=PKW(P1,6), pw2); \
    VRD(3); SBAR(); GAPA(C0=__builtin_amdgcn_mfma_f32_32x32x16_bf16(kf[6],qr[3],C0,0,0,0),   P1[10],P1[11],P1[12],P1[13], pw3[0]=PKW(P1,8), pw3[1]=PKW(P1,10), pw3); \
    VRD(7); SBAR(); GAPA(C1=__builtin_amdgcn_mfma_f32_32x32x16_bf16(kf[7],qr[3],C1,0,0,0),   P1[14],P1[15],0.f,0.f,       pw3[2]=PKW(P1,12),pw3[3]=PKW(P1,14), pw3); \
    l_reg+=sacc; \
    if(GK){DMA_K((t)+3,sl_cur);} if(GV){DMA_V((t)+1,sl_next);} \
    CMASK(C0,C1,t); \
    { float a=MX3(C0[0],C0[1],C1[0]),b=MX3(C0[2],C0[3],C1[1]); a=MX3(a,C1[2],C1[3]); \
      _Pragma("unroll") for(int r=4;r<16;r+=4){a=MX3(a,C0[r],C0[r+1]);b=MX3(b,C0[r+2],C0[r+3]);a=MX3(a,C1[r],C1[r+1]);b=MX3(b,C1[r+2],C1[r+3]);} \
      float rm=__builtin_fmaxf(a,b); { auto rr=__builtin_amdgcn_permlane32_swap(__float_as_uint(rm),__float_as_uint(rm),false,false); rm=__builtin_fmaxf(__uint_as_float(rr[0]),__uint_as_float(rr[1])); } \
      resc=false; \
      if(__builtin_expect(__any(rm>(float)THRL),0)){ const float dl=__builtin_fmaxf(rm,0.f); mhat+=dl; \
        _Pragma("unroll") for(int r=0;r<16;++r){C0[r]-=dl;C1[r]-=dl;} \
        _Pragma("unroll") for(int r=0;r<16;++r)negm[r]=-mhat; asm volatile("":"+v"(negm)); \
        const float f=__builtin_amdgcn_exp2f(-dl); l_reg*=f; if(hi==0)wsf[r32]=f; resc=true; } } \
    SBAR(); \
    GAPB(o[0]=__builtin_amdgcn_mfma_f32_32x32x16_bf16(PAF(0),VFR(0),o[0],0,0,0), C0,0); \
    GAPB(o[1]=__builtin_amdgcn_mfma_f32_32x32x16_bf16(PAF(0),VFR(4),o[1],0,0,0), C0,4); \
    KRD(GL,0); GAPB(o[0]=__builtin_amdgcn_mfma_f32_32x32x16_bf16(PAF(1),VFR(1),o[0],0,0,0), C0,8); \
    KRD(GL,1); GAPB(o[1]=__builtin_amdgcn_mfma_f32_32x32x16_bf16(PAF(1),VFR(5),o[1],0,0,0), C0,12); \
    KRD(GL,2); GAPB(o[0]=__builtin_amdgcn_mfma_f32_32x32x16_bf16(PAF(2),VFR(2),o[0],0,0,0), C1,0); \
    KRD(GL,3); GAPB(o[1]=__builtin_amdgcn_mfma_f32_32x32x16_bf16(PAF(2),VFR(6),o[1],0,0,0), C1,4); \
    GAPB(o[0]=__builtin_amdgcn_mfma_f32_32x32x16_bf16(PAF(3),VFR(3),o[0],0,0,0), C1,8); \
    GAPB(o[1]=__builtin_amdgcn_mfma_f32_32x32x16_bf16(PAF(3),VFR(7),o[1],0,0,0), C1,12); \
    }while(0)
  int t=1;
  #undef CMASK
  #define CMASK(P0,P1,t) do{}while(0)
  for(;t+5<NT;t+=2){
    STEP(pB0,pB1,pA0,pA1,t,true,true,true);     WAIT_BAR(2); RESC(); ROT();
    STEP(pA0,pA1,pB0,pB1,t+1,true,true,true);   WAIT_BAR(2); RESC(); ROT();
  }
  #undef CMASK
  #define CMASK(P0,P1,t) do{int jb_=(t)-(NT-4); if(jb_>=0)cmask(P0,P1,jb_,qrel,hi);}while(0)
  #define ENDW(tt) do{ if((tt)+3<NT){WAIT_BAR(2);} else if((tt)+2<NT){WAIT_BAR(1);} else {WAIT_BAR(0);} }while(0)
  for(;t+1<NT;t+=2){
    STEP(pB0,pB1,pA0,pA1,t,(t+3<NT),(t+1<NT),(t+1<NT));       ENDW(t);   RESC(); ROT();
    STEP(pA0,pA1,pB0,pB1,t+1,(t+4<NT),(t+2<NT),(t+2<NT));     ENDW(t+1); RESC(); ROT();
  }
  STEP(pB0,pB1,pA0,pA1,NT-1,false,false,false); RESC();
  { float sacc=pB0[0]+pB0[1]; _Pragma("unroll") for(int r=2;r<16;++r)sacc+=pB0[r]; _Pragma("unroll") for(int r=0;r<16;++r)sacc+=pB1[r]; l_reg+=sacc;
    pw0=(u32x4){PKW(pB0,0),PKW(pB0,2),PKW(pB0,4),PKW(pB0,6)};pw1=(u32x4){PKW(pB0,8),PKW(pB0,10),PKW(pB0,12),PKW(pB0,14)};pw2=(u32x4){PKW(pB1,0),PKW(pB1,2),PKW(pB1,4),PKW(pB1,6)};pw3=(u32x4){PKW(pB1,8),PKW(pB1,10),PKW(pB1,12),PKW(pB1,14)};
    SBAR(); pv(o,vb0+sl_cur,PAF(0),PAF(1),PAF(2),PAF(3)); }
  #undef PKW
  #undef PAF
  #undef VFR
  #undef PIN
  #undef MX3
  #undef GAPA
  #undef GAPB
  #undef EX
  #undef VRD
  #undef KRD
  #undef STEP
  #undef ENDW
  {auto rr=__builtin_amdgcn_permlane32_swap(__float_as_uint(l_reg),__float_as_uint(l_reg),false,false);l_reg=__uint_as_float(rr[0])+__uint_as_float(rr[1]);}
  if(hi==0)wsf[32+r32]=l_reg;asm volatile("s_waitcnt lgkmcnt(0)":::"memory");
  float rli[16];
  #pragma unroll
  for(int r=0;r<16;++r)rli[r]=__builtin_amdgcn_rcpf(wsf[32+crow(r,hi)]);
  int lane_e=lane; asm volatile("":"+v"(lane_e));
  bf16*Ow=O+(rowbase+q0+wid*QBLK)*PO+co;
  { bf16*stg=(bf16*)(shm+LDS_OST)+wid*2048;
    #pragma unroll
    for(int r=0;r<16;++r){const int orow=crow(r,hi);
      #pragma unroll
      for(int d0=0;d0<2;++d0)stg[orow*64+d0*32+r32]=__float2bfloat16(o[d0][r]*rli[r]);}
    asm volatile("s_waitcnt lgkmcnt(0)":::"memory");
    #pragma unroll
    for(int i=0;i<4;++i){const int row=i*8+(lane_e>>3),ch=lane_e&7; const u32x4 v=*(const u32x4*)(stg+row*64+ch*8); ATTN_STORE16(Ow+(long)row*PO+ch*8,v);} }
  asm volatile("s_waitcnt lgkmcnt(0)\n\ts_barrier":::"memory");
  #undef DMA_K
  #undef DMA_V
  #undef CMASK
  #undef START
  #undef RESC
  #undef ROT
}

constexpr int VSLOTB=2*SLOTB;
constexpr int L2_K=0, L2_V=NSLOT*SLOTB, L2_WS=L2_V+NSLOT*VSLOTB, L2_OST=L2_WS+NW*64*4, LDS128_BYTES=L2_OST+NW*4096;
__device__ __forceinline__ void pv128(f32x16*o,int vb,bf16x8 pa0,bf16x8 pa1,bf16x8 pa2,bf16x8 pa3){
  #pragma unroll
  for(int d0=0;d0<4;++d0){s16x4 lo[4],hi[4];
    #pragma unroll
    for(int ks=0;ks<4;++ks){
      asm volatile("ds_read_b64_tr_b16 %0,%1 offset:%c2":"=&v"(lo[ks]):"v"(vb),"i"(d0*4096+ks*1024):"memory");
      asm volatile("ds_read_b64_tr_b16 %0,%1 offset:%c2":"=&v"(hi[ks]):"v"(vb),"i"(d0*4096+ks*1024+512):"memory");}
    asm volatile("s_waitcnt lgkmcnt(0)":::"memory");SBAR();
    #define PK(k) (bf16x8){lo[k][0],lo[k][1],lo[k][2],lo[k][3],hi[k][0],hi[k][1],hi[k][2],hi[k][3]}
    o[d0]=__builtin_amdgcn_mfma_f32_32x32x16_bf16(pa0,PK(0),o[d0],0,0,0);
    o[d0]=__builtin_amdgcn_mfma_f32_32x32x16_bf16(pa1,PK(1),o[d0],0,0,0);
    o[d0]=__builtin_amdgcn_mfma_f32_32x32x16_bf16(pa2,PK(2),o[d0],0,0,0);
    o[d0]=__builtin_amdgcn_mfma_f32_32x32x16_bf16(pa3,PK(3),o[d0],0,0,0);
    #undef PK
  }
}
template<int THRL> __device__ __forceinline__ void attn_unit128(int b,int cqk,int cv,int co,int qb,const bf16*Q,const bf16*__restrict__ K,const bf16*__restrict__ V,bf16*O,char*shm,const int tid_in){
  int tid=tid_in; asm volatile("":"+v"(tid));
  const int lane=tid&63,r32=lane&31,hi=lane>>5; const int wid=__builtin_amdgcn_readfirstlane(tid>>6);
  const long gsl=(long)(b>>1)*((long)16<<20); const long rowbase=(long)(b&1)*SEQL; const int q0=qb*QB;
  const long pq0=(((rowbase+q0)>>8)<<20), pb0=((rowbase>>8)<<20);
  const bf16*Qw=Q+gsl+pq0+(long)(wid*QBLK)*PQ+cqk;
  const bf16*Kh=K+gsl+pb0+cqk,*Vh=V+gsl+pb0+cv;
  const unsigned lds0=(unsigned)(uintptr_t)shm;
  float*wsf=(float*)(shm+L2_WS)+wid*64;
  const bf16*ksrc=Kh+(long)lane*PQ+wid*8;
  const bf16*vsrc=Vh+(long)(16*(wid&3)+(lane>>2))*PQ+(wid>>2)*32+(lane&3)*8;
  const unsigned kdst=lds0+L2_K+wid*1024, vdst=lds0+L2_V+wid*1024;
  #define TOFF(t) ((((long)(t)>>2)<<20)+((long)(t)&3)*(KVBLK*PQ))
  #define DMA_K(t,slot) glds16(ksrc+TOFF(t),(unsigned)__builtin_amdgcn_readfirstlane(kdst+(slot)))
  #define DMA_V(t,slot) do{ glds16(vsrc+TOFF(t),(unsigned)__builtin_amdgcn_readfirstlane(vdst+2*(slot))); glds16(vsrc+TOFF(t)+64,(unsigned)__builtin_amdgcn_readfirstlane(vdst+2*(slot)+8192)); }while(0)
  const int vb0=(int)(lds0+L2_V)+((lane>>4)&1)*32+(lane&3)*8+(4*hi+((lane&15)>>2))*64;
  const char*Kbase=shm+L2_K; bf16x8 kf[8];
  const lds_cptr shm3=(lds_cptr)shm; const lds_cptr kp0=shm3+L2_K+hi*1024+r32*16; const lds_cptr vp0=shm3+L2_V+((lane>>4)&1)*32+(lane&3)*8+(4*hi+((lane&15)>>2))*64;
  const int NT=(q0+QB)/KVBLK;
  DMA_K(0,0);DMA_V(0,0);DMA_K(1,SLOTB);
  bf16x8 qr[4];
  #pragma unroll
  for(int d0=0;d0<4;++d0)qr[d0]=*reinterpret_cast<const bf16x8*>(&Qw[(long)r32*PQ+d0*16+hi*8]);
  float zz_=0.f;asm volatile("":"+v"(zz_));float mhat=zz_,l_reg=zz_;f32x16 o[4];
  _Pragma("unroll") for(int r=0;r<16;++r){o[0][r]=zz_;o[1][r]=zz_;o[2][r]=zz_;o[3][r]=zz_;}
  const f32x16 z16=f32x16{};
  const int qrel=wid*QBLK+r32;
  #define CMASK(P0,P1,t) do{int jb_=(t)-(NT-4); if(jb_>=0)cmask(P0,P1,jb_,qrel,hi);}while(0)
  bool resc=false;
  #define RESC() do{ if(resc){ asm volatile("s_waitcnt lgkmcnt(0)":::"memory"); \
      _Pragma("unroll") for(int d_=0;d_<4;++d_) _Pragma("unroll") for(int r=0;r<16;++r)o[d_][r]*=wsf[crow(r,hi)]; } }while(0)
  f32x16 pA0,pA1,pB0,pB1;
  int sl_prev=0,sl_cur=0,sl_next=SLOTB;
  #define ROT() do{sl_prev=sl_cur;sl_cur=sl_next;sl_next=(sl_next==(NSLOT-1)*SLOTB)?0:sl_next+SLOTB;}while(0)
  DMA_K(2,2*SLOTB);
  asm volatile("s_waitcnt vmcnt(3) lgkmcnt(0)\n\ts_barrier":::"memory");
  { const char*kb=Kbase+hi*1024+r32*16;
    #pragma unroll
    for(int d0=0;d0<4;++d0){ const bf16x8 b0=*reinterpret_cast<const bf16x8*>(kb+d0*2048); const bf16x8 b1=*reinterpret_cast<const bf16x8*>(kb+d0*2048+512);
      if(d0==0){pA0=__builtin_amdgcn_mfma_f32_32x32x16_bf16(b0,qr[0],z16,0,0,0);pA1=__builtin_amdgcn_mfma_f32_32x32x16_bf16(b1,qr[0],z16,0,0,0);}
      else{pA0=__builtin_amdgcn_mfma_f32_32x32x16_bf16(b0,qr[d0],pA0,0,0,0);pA1=__builtin_amdgcn_mfma_f32_32x32x16_bf16(b1,qr[d0],pA1,0,0,0);}} }
  asm volatile("s_nop 15\n\ts_nop 7":"+v"(pA0),"+v"(pA1));CMASK(pA0,pA1,0);
  { const float rm=rowmax(pA0,pA1); mhat=fadd_s(mhat,rm);
    _Pragma("unroll") for(int r=0;r<16;++r)pA0[r]=__builtin_amdgcn_exp2f(fsub_s(pA0[r],mhat));
    _Pragma("unroll") for(int r=0;r<16;++r)pA1[r]=__builtin_amdgcn_exp2f(fsub_s(pA1[r],mhat)); }
  asm volatile("s_waitcnt vmcnt(0) lgkmcnt(0)\n\ts_barrier":::"memory");
  DMA_K(3,0);DMA_V(1,SLOTB);
  ROT();
  kload8(kf,kp0+sl_cur);
  asm volatile("s_waitcnt vmcnt(3) lgkmcnt(0)\n\ts_barrier":::"memory");
  s16x4 vlo[8],vhi[8]; u32x4 pw0,pw1,pw2,pw3;
  #define PKW(P,B) cvtpk_s(P[B],P[B+1])
  #define PAF(k) __builtin_bit_cast(bf16x8,pw##k)
  #define VFR(i) (bf16x8){vlo[i][0],vlo[i][1],vlo[i][2],vlo[i][3],vhi[i][0],vhi[i][1],vhi[i][2],vhi[i][3]}
  #define PIN(x) asm volatile("":"+v"(x))
  #define MX3(a,b,c) __builtin_fmaxf(__builtin_fmaxf((a),(b)),(c))
  #define GAPA(MF,A0,A1,A2,A3,W0,W1,PW) do{ MF; sacc+=A0; sacc+=A1; sacc+=A2; sacc+=A3; PIN(sacc); W0; W1; PIN(PW); SBAR(); }while(0)
  #define EXM(v) __builtin_amdgcn_exp2f(fsub_s((v),mhat))
  #define GAPB(MF,X,B) do{ MF; X[B]=EXM(X[B]); X[B+1]=EXM(X[B+1]); PIN(X); SBAR(); }while(0)
  #define VRD(i) do{ vlo[i]=vtr(vp_+(((i)>>2)*4096+((i)&3)*1024)); vhi[i]=vtr(vp_+(((i)>>2)*4096+((i)&3)*1024+512)); }while(0)
  #define VRD2(i) do{ vlo[i]=vtr(vp_+(8192+((i)>>2)*4096+((i)&3)*1024)); vhi[i]=vtr(vp_+(8192+((i)>>2)*4096+((i)&3)*1024+512)); SBAR(); }while(0)
  #define KRD(G,j) do{ if(G){ kload2(kf,kp0+sl_next,j); SBAR(); } }while(0)
  #define STEP(C0,C1,P0,P1,t,GK,GV,GL) do{ SBAR(); \
    const lds_cptr vp_=vp0+2*sl_prev; \
    VRD(0); SBAR(); float sacc=(P0[0]+P0[1]); \
    GAPA(C0=__builtin_amdgcn_mfma_f32_32x32x16_bf16(kf[0],qr[0],z16,0,0,0), P0[2],P0[3],P0[4],P0[5],     pw0[0]=PKW(P0,0), pw0[1]=PKW(P0,2), pw0); \
    VRD(4); SBAR(); GAPA(C1=__builtin_amdgcn_mfma_f32_32x32x16_bf16(kf[1],qr[0],z16,0,0,0), P0[6],P0[7],P0[8],P0[9],     pw0[2]=PKW(P0,4), pw0[3]=PKW(P0,6), pw0); \
    VRD(1); SBAR(); GAPA(C0=__builtin_amdgcn_mfma_f32_32x32x16_bf16(kf[2],qr[1],C0,0,0,0),   P0[10],P0[11],P0[12],P0[13], pw1[0]=PKW(P0,8), pw1[1]=PKW(P0,10), pw1); \
    VRD(5); SBAR(); GAPA(C1=__builtin_amdgcn_mfma_f32_32x32x16_bf16(kf[3],qr[1],C1,0,0,0),   P0[14],P0[15],P1[0],P1[1],   pw1[2]=PKW(P0,12),pw1[3]=PKW(P0,14), pw1); \
    VRD(2); SBAR(); GAPA(C0=__builtin_amdgcn_mfma_f32_32x32x16_bf16(kf[4],qr[2],C0,0,0,0),   P1[2],P1[3],P1[4],P1[5],     pw2[0]=PKW(P1,0), pw2[1]=PKW(P1,2), pw2); \
    VRD(6); SBAR(); GAPA(C1=__builtin_amdgcn_mfma_f32_32x32x16_bf16(kf[5],qr[2],C1,0,0,0),   P1[6],P1[7],P1[8],P1[9],     pw2[2]=PKW(P1,4), pw2[3]=PKW(P1,6), pw2); \
    VRD(3); SBAR(); GAPA(C0=__builtin_amdgcn_mfma_f32_32x32x16_bf16(kf[6],qr[3],C0,0,0,0),   P1[10],P1[11],P1[12],P1[13], pw3[0]=PKW(P1,8), pw3[1]=PKW(P1,10), pw3); \
    VRD(7); SBAR(); GAPA(C1=__builtin_amdgcn_mfma_f32_32x32x16_bf16(kf[7],qr[3],C1,0,0,0),   P1[14],P1[15],0.f,0.f,       pw3[2]=PKW(P1,12),pw3[3]=PKW(P1,14), pw3); \
    l_reg+=sacc; \
    if(GK){DMA_K((t)+3,sl_cur);} if(GV){DMA_V((t)+1,sl_next);} \
    CMASK(C0,C1,t); \
    { float a=MX3(C0[0],C0[1],C1[0]),b=MX3(C0[2],C0[3],C1[1]); a=MX3(a,C1[2],C1[3]); \
      _Pragma("unroll") for(int r=4;r<16;r+=4){a=MX3(a,C0[r],C0[r+1]);b=MX3(b,C0[r+2],C0[r+3]);a=MX3(a,C1[r],C1[r+1]);b=MX3(b,C1[r+2],C1[r+3]);} \
      float rm=__builtin_fmaxf(a,b); { auto rr=__builtin_amdgcn_permlane32_swap(__float_as_uint(rm),__float_as_uint(rm),false,false); rm=__builtin_fmaxf(__uint_as_float(rr[0]),__uint_as_float(rr[1])); } \
      resc=false; const float gr_=rm-mhat; \
      if(__builtin_expect(__any(gr_>(float)THRL),0)){ const float dl=__builtin_fmaxf(gr_,0.f); mhat+=dl; \
        const float f=__builtin_amdgcn_exp2f(-dl); l_reg*=f; if(hi==0)wsf[r32]=f; resc=true; } } \
    SBAR(); \
    GAPB(o[0]=__builtin_amdgcn_mfma_f32_32x32x16_bf16(PAF(0),VFR(0),o[0],0,0,0), C0,0);  VRD2(0); \
    GAPB(o[1]=__builtin_amdgcn_mfma_f32_32x32x16_bf16(PAF(0),VFR(4),o[1],0,0,0), C0,2);  VRD2(4); \
    GAPB(o[0]=__builtin_amdgcn_mfma_f32_32x32x16_bf16(PAF(1),VFR(1),o[0],0,0,0), C0,4);  VRD2(1); \
    GAPB(o[1]=__builtin_amdgcn_mfma_f32_32x32x16_bf16(PAF(1),VFR(5),o[1],0,0,0), C0,6);  VRD2(5); \
    GAPB(o[0]=__builtin_amdgcn_mfma_f32_32x32x16_bf16(PAF(2),VFR(2),o[0],0,0,0), C0,8);  VRD2(2); \
    GAPB(o[1]=__builtin_amdgcn_mfma_f32_32x32x16_bf16(PAF(2),VFR(6),o[1],0,0,0), C0,10); VRD2(6); \
    GAPB(o[0]=__builtin_amdgcn_mfma_f32_32x32x16_bf16(PAF(3),VFR(3),o[0],0,0,0), C0,12); VRD2(3); \
    GAPB(o[1]=__builtin_amdgcn_mfma_f32_32x32x16_bf16(PAF(3),VFR(7),o[1],0,0,0), C0,14); VRD2(7); \
    GAPB(o[2]=__builtin_amdgcn_mfma_f32_32x32x16_bf16(PAF(0),VFR(0),o[2],0,0,0), C1,0); \
    GAPB(o[3]=__builtin_amdgcn_mfma_f32_32x32x16_bf16(PAF(0),VFR(4),o[3],0,0,0), C1,2); \
    KRD(GL,0); GAPB(o[2]=__builtin_amdgcn_mfma_f32_32x32x16_bf16(PAF(1),VFR(1),o[2],0,0,0), C1,4); \
    KRD(GL,1); GAPB(o[3]=__builtin_amdgcn_mfma_f32_32x32x16_bf16(PAF(1),VFR(5),o[3],0,0,0), C1,6); \
    KRD(GL,2); GAPB(o[2]=__builtin_amdgcn_mfma_f32_32x32x16_bf16(PAF(2),VFR(2),o[2],0,0,0), C1,8); \
    KRD(GL,3); GAPB(o[3]=__builtin_amdgcn_mfma_f32_32x32x16_bf16(PAF(2),VFR(6),o[3],0,0,0), C1,10); \
    GAPB(o[2]=__builtin_amdgcn_mfma_f32_32x32x16_bf16(PAF(3),VFR(3),o[2],0,0,0), C1,12); \
    GAPB(o[3]=__builtin_amdgcn_mfma_f32_32x32x16_bf16(PAF(3),VFR(7),o[3],0,0,0), C1,14); \
    }while(0)
  #define WB3() asm volatile("s_waitcnt vmcnt(3) lgkmcnt(0)\n\ts_barrier":::"memory")
  #define WB2() asm volatile("s_waitcnt vmcnt(2) lgkmcnt(0)\n\ts_barrier":::"memory")
  #define WB0() asm volatile("s_waitcnt vmcnt(0) lgkmcnt(0)\n\ts_barrier":::"memory")
  int t=1;
  #undef CMASK
  #define CMASK(P0,P1,t) do{}while(0)
  for(;t+5<NT;t+=2){
    STEP(pB0,pB1,pA0,pA1,t,true,true,true);     WB3(); RESC(); ROT();
    STEP(pA0,pA1,pB0,pB1,t+1,true,true,true);   WB3(); RESC(); ROT();
  }
  #undef CMASK
  #define CMASK(P0,P1,t) do{int jb_=(t)-(NT-4); if(jb_>=0)cmask(P0,P1,jb_,qrel,hi);}while(0)
  #define ENDW(tt) do{ if((tt)+3<NT){WB3();} else if((tt)+2<NT){WB2();} else {WB0();} }while(0)
  for(;t+1<NT;t+=2){
    STEP(pB0,pB1,pA0,pA1,t,(t+3<NT),(t+1<NT),(t+1<NT));       ENDW(t);   RESC(); ROT();
    STEP(pA0,pA1,pB0,pB1,t+1,(t+4<NT),(t+2<NT),(t+2<NT));     ENDW(t+1); RESC(); ROT();
  }
  STEP(pB0,pB1,pA0,pA1,NT-1,false,false,false); RESC();
  { float sacc=pB0[0]+pB0[1]; _Pragma("unroll") for(int r=2;r<16;++r)sacc+=pB0[r]; _Pragma("unroll") for(int r=0;r<16;++r)sacc+=pB1[r]; l_reg+=sacc;
    pw0=(u32x4){PKW(pB0,0),PKW(pB0,2),PKW(pB0,4),PKW(pB0,6)};pw1=(u32x4){PKW(pB0,8),PKW(pB0,10),PKW(pB0,12),PKW(pB0,14)};pw2=(u32x4){PKW(pB1,0),PKW(pB1,2),PKW(pB1,4),PKW(pB1,6)};pw3=(u32x4){PKW(pB1,8),PKW(pB1,10),PKW(pB1,12),PKW(pB1,14)};
    SBAR(); pv128(o,vb0+2*sl_cur,PAF(0),PAF(1),PAF(2),PAF(3)); }
  #undef PKW
  #undef PAF
  #undef VFR
  #undef PIN
  #undef MX3
  #undef GAPA
  #undef GAPB
  #undef EXM
  #undef VRD
  #undef VRD2
  #undef KRD
  #undef STEP
  #undef ENDW
  #undef WB3
  #undef WB2
  #undef WB0
  {auto rr=__builtin_amdgcn_permlane32_swap(__float_as_uint(l_reg),__float_as_uint(l_reg),false,false);l_reg=__uint_as_float(rr[0])+__uint_as_float(rr[1]);}
  if(hi==0)wsf[32+r32]=l_reg;asm volatile("s_waitcnt lgkmcnt(0)":::"memory");
  float rli[16];
  #pragma unroll
  for(int r=0;r<16;++r)rli[r]=__builtin_amdgcn_rcpf(wsf[32+crow(r,hi)]);
  int lane_e=lane; asm volatile("":"+v"(lane_e));
  bf16*Ow=O+gsl+pq0+(long)(wid*QBLK)*PO+co;
  { bf16*stg=(bf16*)(shm+L2_OST)+wid*2048;
    #pragma unroll
    for(int hf=0;hf<2;++hf){
      #pragma unroll
      for(int r=0;r<16;++r){const int orow=crow(r,hi);
        #pragma unroll
        for(int d0=0;d0<2;++d0)stg[orow*64+d0*32+r32]=__float2bfloat16(o[2*hf+d0][r]*rli[r]);}
      asm volatile("s_waitcnt lgkmcnt(0)":::"memory");
      #pragma unroll
      for(int i=0;i<4;++i){const int row=i*8+(lane_e>>3),ch=lane_e&7; const u32x4 v=*(const u32x4*)(stg+row*64+ch*8); ATTN_STORE16(Ow+(long)row*PO+hf*64+ch*8,v);}
      asm volatile("s_waitcnt lgkmcnt(0)":::"memory"); } }
  asm volatile("s_waitcnt lgkmcnt(0)\n\ts_barrier":::"memory");
  #undef DMA_K
  #undef TOFF
  #undef DMA_V
  #undef CMASK
  #undef RESC
  #undef ROT
}
constexpr int ATTN_LDS_BYTES=LDS_BYTES;
#undef SBAR
#undef WAIT_BAR
}

constexpr int NWAVES = 8;
constexpr size_t MiB = 1u << 20;
constexpr size_t WS_CTL = 0, CTL_ZERO_BYTES = 3 * MiB;
constexpr size_t WS_ROWSS = 1 * MiB;
constexpr size_t WS_CS = 492 * MiB;
constexpr size_t WS_W = 4 * MiB, W_LAYER = 32 * MiB;
constexpr size_t WO_IN = 0, WO_MIX = 6 * MiB, WO_QG = 8 * MiB, WO_O = 10 * MiB, WO_KV = 12 * MiB, WO_1 = 16 * MiB, WO_2 = 24 * MiB;
constexpr size_t WS_MEMN = 68 * MiB;
constexpr size_t WS_KV = 76 * MiB, KV_LAYER = 16 * MiB;
constexpr size_t WS_WQK = 108 * MiB, WS_VWO = 140 * MiB;
constexpr size_t WS_HB = 172 * MiB;
constexpr size_t WS_X = 236 * MiB;
constexpr size_t KiB = 1024;
constexpr size_t X_Q = 0, X_K = 256 * KiB, X_V = 512 * KiB, X_BG = 768 * KiB, X_U = 1024 * KiB, X_O = 1280 * KiB, X_MIX = 0, X_P = 512 * KiB, X_F = 0;
constexpr size_t WS_END = 494 * MiB;
constexpr int CW_BAR = 4096;

constexpr int RING_OFF = 0, RING_BYTES = 131072;
constexpr int LDSCTL_OFF = RING_BYTES, MISC_OFF = LDSCTL_OFF + 320, EPIX_OFF = RING_BYTES + 1024;
constexpr int LDS_BYTES = 147456;
static_assert(EPIX_OFF + 8192 <= LDS_BYTES && MISC_OFF + 128 <= EPIX_OFF, "LDS map");

#define GAS __attribute__((address_space(1)))
#define LAS __attribute__((address_space(3)))
typedef unsigned short bf16;
typedef unsigned v4u __attribute__((ext_vector_type(4)));
typedef unsigned v2u __attribute__((ext_vector_type(2)));
typedef float f32x4 __attribute__((ext_vector_type(4)));
typedef GAS unsigned gu32;
#define RLX_AGENT __ATOMIC_RELAXED, __HIP_MEMORY_SCOPE_AGENT
#define LDS_WAIT() asm volatile("s_waitcnt lgkmcnt(0)" ::: "memory")
#define VM_WAIT() asm volatile("s_waitcnt vmcnt(0)" ::: "memory")
__device__ __forceinline__ unsigned f2bf(float f) { unsigned u = __builtin_bit_cast(unsigned, f); return (u + 0x7fffu + ((u >> 16) & 1u)) >> 16; }
__device__ __forceinline__ unsigned pk2(float lo, float hi) { return f2bf(lo) | (f2bf(hi) << 16); }
__device__ __forceinline__ float bflo(unsigned w) { return __uint_as_float(w << 16); }
__device__ __forceinline__ float bfhi(unsigned w) { return __uint_as_float(w & 0xffff0000u); }

#define XB_TMO      128
#define XB_XCNT(j)  (256  + 64 * (j))
#define XB_XSUB(j)  (1280 + 64 * (j))
#define XB_XGEN(j)  (2304 + 64 * (j))
#define XB_TOP      3328
#define XB_TOPGEN   3392
#define XCD_BAR_WORDS 3456
#define XB_LSUB(j)  (3520 + 64 * (j))
#define XB_XID(w)   (4608 + (w))
#define XB_PAIR(i)  (8192 + 16 * (i))
#define XB_BAD      4928
#define XB_SPIN_CAP (1u << 18)
__device__ __forceinline__ unsigned xb_ld(unsigned* p)              { return __hip_atomic_load(p, __ATOMIC_RELAXED, __HIP_MEMORY_SCOPE_AGENT); }
__device__ __forceinline__ unsigned xb_add(unsigned* p, unsigned v) { return __hip_atomic_fetch_add(p, v, __ATOMIC_RELAXED, __HIP_MEMORY_SCOPE_AGENT); }
__device__ __forceinline__ unsigned xb_xcc_id() { return (unsigned)__builtin_amdgcn_s_getreg((3 << 11) | 20) & 0xFu; }
#define XB_SPIN(cond, bar) do { unsigned _sp = 0; while (cond) { __builtin_amdgcn_s_sleep(1); \
    if ((++_sp & 255u) == 0u) { if (xb_ld(&(bar)[XB_TMO])) break; if (_sp > XB_SPIN_CAP) { atomicAdd(&(bar)[XB_TMO], 1u); break; } } } } while (0)
struct XcdBarrier { unsigned* bar; unsigned x; volatile LAS unsigned* st; };
__device__ __forceinline__ XcdBarrier xcd_barrier_post(unsigned* bar, volatile LAS unsigned* st) {
    XcdBarrier b; b.bar = bar; b.x = xb_xcc_id(); b.st = st;
    if (threadIdx.x == 0) (void)xb_add(&bar[XB_XCNT(b.x)], 1u);
    return b;
}
__device__ __forceinline__ void xcd_barrier_complete(unsigned* bar, unsigned x, unsigned& nloc, unsigned& nx) {
    const unsigned G = gridDim.x * gridDim.y * gridDim.z;
    unsigned sum, cnt, mine, sp = 0u;
    for (;;) {
        sum = 0u; cnt = 0u; mine = 0u;
#pragma unroll
        for (unsigned j = 0; j < 16; ++j) { const unsigned c = xb_ld(&bar[XB_XCNT(j)]); sum += c; cnt += (c > 0u) ? 1u : 0u; }
        mine = xb_ld(&bar[XB_XCNT(x)]);
        if (sum == G) break;
        __builtin_amdgcn_s_sleep(1);
        if ((++sp & 255u) == 0u) { if (xb_ld(&bar[XB_TMO])) break; if (sp > XB_SPIN_CAP) { atomicAdd(&bar[XB_TMO], 1u); break; } }
    }
    nloc = mine > 0u ? mine : 1u; nx = cnt > 0u ? cnt : 1u;
}
__device__ __forceinline__ void xcd_barrier(const XcdBarrier& b, const bool leader) {
    asm volatile("s_waitcnt vmcnt(0)" ::: "memory");
    __syncthreads();
    if (leader) {
        unsigned* bar = b.bar;
        __builtin_amdgcn_s_waitcnt(0);
        unsigned nloc = b.st[0], nx = b.st[1];
        if (nloc == 0u) { xcd_barrier_complete(bar, b.x, nloc, nx); b.st[0] = nloc; b.st[1] = nx; }
        const unsigned old = xb_add(&bar[XB_XSUB(b.x)], 1u);
        const unsigned gen = old / nloc;
        if (old + 1u == (gen + 1u) * nloc) {
            __builtin_amdgcn_fence(__ATOMIC_RELEASE, "agent");
            asm volatile("s_waitcnt vmcnt(0)" ::: "memory");
            const unsigned og = xb_add(&bar[XB_TOP], 1u);
            const unsigned tg = og / nx;
            if (og + 1u == (tg + 1u) * nx) xb_add(&bar[XB_TOPGEN], 1u);
            else XB_SPIN(xb_ld(&bar[XB_TOPGEN]) == tg, bar);
            __builtin_amdgcn_fence(__ATOMIC_ACQUIRE, "agent");
            xb_add(&bar[XB_XGEN(b.x)], 1u);
            asm volatile("s_waitcnt vmcnt(0)" ::: "memory");
        } else {
            XB_SPIN(xb_ld(&bar[XB_XGEN(b.x)]) == gen, bar);
            __builtin_amdgcn_fence(__ATOMIC_ACQUIRE, "agent");
            asm volatile("s_waitcnt vmcnt(0)" ::: "memory");
        }
    }
    __syncthreads();
}

__device__ __forceinline__ void pair_barrier(const XcdBarrier& b, const bool leader, const int pi) {
    asm volatile("s_waitcnt vmcnt(0)" ::: "memory");
    __syncthreads();
    if (leader) {
        unsigned* bar = b.bar;
        __builtin_amdgcn_s_waitcnt(0);
        const unsigned k = b.st[3] + 1u; b.st[3] = k;
        const unsigned target = 4u * k;
        (void)__hip_atomic_fetch_add(&bar[XB_PAIR(pi)], 1u, __ATOMIC_RELAXED, __HIP_MEMORY_SCOPE_AGENT);
        XB_SPIN(xb_ld(&bar[XB_PAIR(pi)]) < target, bar);
        __builtin_amdgcn_fence(__ATOMIC_ACQUIRE, "agent");
        asm volatile("s_waitcnt vmcnt(0)" ::: "memory");
    }
    __syncthreads();
}

__device__ __forceinline__ void xcc_barrier(const XcdBarrier& b, const bool leader) {
    asm volatile("s_waitcnt vmcnt(0)" ::: "memory");
    __syncthreads();
    if (leader) {
        unsigned* bar = b.bar;
        __builtin_amdgcn_s_waitcnt(0);
        const unsigned nloc = b.st[0];
        const unsigned k = b.st[2] + 1u; b.st[2] = k;
        const unsigned target = k * nloc;
        (void)__hip_atomic_fetch_add(&bar[XB_LSUB(b.x)], 1u, __ATOMIC_RELAXED, __HIP_MEMORY_SCOPE_AGENT);
        XB_SPIN(xb_ld(&bar[XB_LSUB(b.x)]) < target, bar);
        __builtin_amdgcn_fence(__ATOMIC_ACQUIRE, "agent");
        asm volatile("s_waitcnt vmcnt(0)" ::: "memory");
    }
    __syncthreads();
}

struct Frame {
    LAS unsigned char* lds;
    int tid, lane, wave, vcu, G, bx;
};
__device__ __forceinline__ float shx(float x, int mask) { unsigned on_ = ~0u; asm volatile("" : "+s"(on_)); const int l = (int)__builtin_amdgcn_mbcnt_hi(on_, __builtin_amdgcn_mbcnt_lo(on_, 0u));
    return __builtin_bit_cast(float, __builtin_amdgcn_ds_bpermute((l ^ mask) << 2, __builtin_bit_cast(int, x))); }
__device__ __forceinline__ float wave_sum(float v) {
#pragma unroll
    for (int o = 1; o < 64; o <<= 1) v += shx(v, o);
    return v;
}

__device__ __forceinline__ void p0_transpose_item(const float* W, int K, int N, bf16* WT, int dst_row0, const float* g, LAS float* scr, int kb, int nb, int lane, const bool tiled) {
    const int k0 = 64 * kb, n0 = 32 * nb;
    float wv[32];
#pragma unroll
    for (int i = 0; i < 32; ++i) { const int kk = 2 * i + (lane >> 5); wv[i] = W[(size_t)(k0 + kk) * N + n0 + (lane & 31)]; }
#pragma unroll
    for (int i = 0; i < 32; ++i) { const int kk = 2 * i + (lane >> 5); float w = wv[i]; if (g) w *= g[k0 + kk]; scr[kk * 33 + (lane & 31)] = w; }
    LDS_WAIT(); asm volatile("" ::: "memory");
    const int c = lane & 7;
#pragma unroll
    for (int j = 0; j < 4; ++j) { const int n = (lane >> 3) + 8 * j; const LAS float* s = scr + (8 * c) * 33 + n;
        v4u o; o.x = pk2(s[0 * 33], s[1 * 33]); o.y = pk2(s[2 * 33], s[3 * 33]); o.z = pk2(s[4 * 33], s[5 * 33]); o.w = pk2(s[6 * 33], s[7 * 33]);
        const size_t off = tiled ? pg8::btile_off(dst_row0 + n, k0 + 8 * c, K) : (size_t)(dst_row0 + n) * K + k0 + 8 * c;
        *(GAS v4u*)(WT + off) = o; }
    LDS_WAIT(); asm volatile("" ::: "memory");
}
__device__ __forceinline__ int win_dst_row(int n) {
    if (n < 2048) return n;
    if (n < 2560) { const int ch = n - 2048; return 2048 + 256 * (ch >> 7) + (ch & 127); }
    const int ch = n - 2560; return 2048 + 256 * (ch >> 7) + 128 + (ch & 127);
}
__device__ __forceinline__ void sincos_d(double x, float& s, float& c) {
    const double k = __builtin_rint(x * 0.63661977236758134308);
    double r = __builtin_fma(-k, 1.57079632679489655800e+00, x); r = __builtin_fma(-k, 6.12323399573676603587e-17, r);
    const double r2 = r * r;
    double sp = -7.6471637318198164759e-13; sp = sp * r2 + 1.6059043836821614599e-10; sp = sp * r2 - 2.5052108385441718775e-08; sp = sp * r2 + 2.7557319223985890653e-06;
    sp = sp * r2 - 1.9841269841269841270e-04; sp = sp * r2 + 8.3333333333333333333e-03; sp = sp * r2 - 1.6666666666666666667e-01; const double sn = r + r * r2 * sp;
    double cp = 4.7794773323873852974e-14; cp = cp * r2 - 1.1470745597729724714e-11; cp = cp * r2 + 2.0876756987868098979e-09; cp = cp * r2 - 2.7557319223985890653e-07;
    cp = cp * r2 + 2.4801587301587301587e-05; cp = cp * r2 - 1.3888888888888888889e-03; cp = cp * r2 + 4.1666666666666666667e-02; const double cn = 1.0 - 0.5 * r2 + r2 * r2 * cp;
    const int q = ((int)(long long)k) & 3;
    const double ss = (q == 0) ? sn : (q == 1) ? cn : (q == 2) ? -sn : -cn;
    const double cc = (q == 0) ? cn : (q == 1) ? -sn : (q == 2) ? -cn : sn;
    s = (float)ss; c = (float)cc;
}

struct Args { const void* in[21]; float* out; unsigned char* ws; int ph_lo, ph_hi, li, pad; };
constexpr int NPH = 18;

#ifndef PROBE_REP
#define PROBE_REP -1
#endif
#define NREP(k) ((PROBE_REP == (k)) ? 2 : 1)
#ifndef PH_MASK
#define PH_MASK 0xfff
#endif
#define PHON(k) (((PH_MASK) >> (k)) & 1)
#define INP(i) ((const float*)args.in[i])
#define WSP(T, off) ((T*)((GAS T*)(wsb + (off))))
__global__ void __launch_bounds__(NWAVES * 64, 2) fwd_kernel(Args args) {
    extern __shared__ __attribute__((aligned(16))) unsigned char lds[];
    Frame F;
    F.lds = (LAS unsigned char*)lds;
    volatile LAS unsigned* MISC = (volatile LAS unsigned*)(F.lds + MISC_OFF);
    F.tid = threadIdx.x; F.lane = F.tid & 63; F.wave = __builtin_amdgcn_readfirstlane(F.tid >> 6);
    const int wave0 = F.wave;
    F.G = gridDim.x; { const int bx = blockIdx.x; F.bx = bx; F.vcu = (F.G % 8 == 0) ? (bx % 8) * (F.G / 8) + bx / 8 : bx; }
    for (int u = F.tid; u < (LDS_BYTES - LDSCTL_OFF) / 4; u += NWAVES * 64) ((LAS unsigned*)(F.lds + LDSCTL_OFF))[u] = 0u;
    __syncthreads();
    XcdBarrier bar; bar.bar = (unsigned*)(args.ws + WS_CTL) + CW_BAR; bar.x = 0; bar.st = nullptr;
    if (!MK_PER_PHASE) { bar = xcd_barrier_post((unsigned*)(args.ws + WS_CTL) + CW_BAR, MISC + 8);
        if (threadIdx.x == 0) __hip_atomic_store(bar.bar + XB_XID(blockIdx.x), bar.x + 1u, RLX_AGENT); }
    bool local_ok = false;

    if (args.ph_lo == 0) {
        GAS unsigned char* wsb = (GAS unsigned char*)args.ws;
        const int gw = F.vcu * NWAVES + F.wave, NGW = F.G * NWAVES;
        for (int rp = 0; rp < NREP(0); ++rp) { if (PHON(0)) {
            LAS float* scr = (LAS float*)(F.lds + RING_OFF + F.wave * 16384);
            constexpr int I_IN = 16 * 96, I_MIX = 16 * 32, I_O = 16 * 32, I_KV = 16 * 64, I_1 = 16 * 128, I_2 = 64 * 32, I_L = I_IN + I_MIX + I_O + I_KV + I_1 + I_2;
            for (int it = gw; it < DEPTH * I_L; it += NGW) {
                const int l = it / I_L; int r = it % I_L; unsigned char* wl = (unsigned char*)(wsb + WS_W + (size_t)l * W_LAYER);
                if (r < I_IN) { const int kb = r / 96, nb = r % 96; p0_transpose_item(INP(4) + (size_t)l * DM * INC, DM, INC, (bf16*)(wl + WO_IN), win_dst_row(32 * nb), INP(3) + l * DM, scr, kb, nb, F.lane, true); continue; } r -= I_IN;
                if (r < I_MIX) { const int kb = r / 32, nb = r % 32; p0_transpose_item(INP(11) + (size_t)l * DM * DM, DM, DM, (bf16*)(wl + WO_MIX), 32 * nb, nullptr, scr, kb, nb, F.lane, true); continue; } r -= I_MIX;
                if (r < I_O) { const int kb = r / 32, nb = r % 32; p0_transpose_item(INP(16) + (size_t)l * DM * DM, DM, DM, (bf16*)(wl + WO_O), 32 * nb, nullptr, scr, kb, nb, F.lane, false); continue; } r -= I_O;
                if (r < I_KV) { const int kb = r / 64, nb = r % 64; p0_transpose_item(INP(15) + (size_t)l * DM * 2 * DM, DM, 2 * DM, (bf16*)(wl + WO_KV), 32 * nb, nullptr, scr, kb, nb, F.lane, true); continue; } r -= I_KV;
                if (r < I_1) { const int kb = r / 128, nb = r % 128; p0_transpose_item(INP(18) + (size_t)l * DM * FF, DM, FF, (bf16*)(wl + WO_1), 32 * nb, INP(17) + l * DM, scr, kb, nb, F.lane, true); continue; } r -= I_1;
                { const int kb = r / 32, nb = r % 32; p0_transpose_item(INP(19) + (size_t)l * FF * DM, FF, DM, (bf16*)(wl + WO_2), 32 * nb, nullptr, scr, kb, nb, F.lane, true); }
            }
            { const int gt = F.vcu * (NWAVES * 64) + F.tid, NGT = F.G * NWAVES * 64;
              const float* w_xq = INP(14); const float* norm_x_g = INP(12);
              for (int it = gt; it < DEPTH * DM * DM / 8; it += NGT) { const int l = it / (DM * DM / 8), e = (it % (DM * DM / 8)) * 8, k = e / DM;
                  const f32x4 a = *(const f32x4*)(w_xq + (size_t)l * DM * DM + e), b = *(const f32x4*)(w_xq + (size_t)l * DM * DM + e + 4); const float g = norm_x_g[l * DM + k];
                  v4u o; o.x = pk2(a[0] * g, a[1] * g); o.y = pk2(a[2] * g, a[3] * g); o.z = pk2(b[0] * g, b[1] * g); o.w = pk2(b[2] * g, b[3] * g);
                  *((GAS v4u*)(wsb + WS_W + (size_t)l * W_LAYER + WO_QG + (size_t)e * 2)) = o; }
              const int* positions = (const int*)args.in[2]; float* cstab = WSP(float, WS_CS);
              for (int it = gt; it < MTOK * 8; it += NGT) { const int row = it >> 3, i = it & 7;
                  double f = 1.0;
                  f = (i == 1) ? 0.19392274474868576 : f; f = (i == 2) ? 0.03760603093086393 : f; f = (i == 3) ? 0.007292664737217109 : f; f = (i == 4) ? 0.001414213562373095 : f;
                  f = (i == 5) ? 0.0002742481756762073 : f; f = (i == 6) ? 5.318295896944988e-05 : f; f = (i == 7) ? 1.031338537721246e-05 : f;
                  float s, c; sincos_d((double)positions[row] * f, s, c); cstab[(size_t)row * 16 + i] = c; cstab[(size_t)row * 16 + 8 + i] = s; }
            }
            { const float* x = INP(0); pg8::rss_t* rowss = WSP(pg8::rss_t, WS_ROWSS); bf16* HB = WSP(bf16, WS_HB); float* out = args.out;
            for (int rb = gw; rb < MTOK / 16; rb += NGW) {
                const int m = rb * 16 + (F.lane >> 2), c4 = F.lane & 3; const float* xr = x + (size_t)m * DM + c4 * 8; bf16* pan = HB + (size_t)(m >> 8) * 256 * DM; float s = 0.f;
#pragma unroll 8
                for (int g = 0; g < 32; ++g) { const f32x4 a = *(const GAS f32x4*)(xr + g * 32), b2 = *(const GAS f32x4*)(xr + g * 32 + 4);
                    s += (a.x * a.x + a.y * a.y) + (a.z * a.z + a.w * a.w) + (b2.x * b2.x + b2.y * b2.y) + (b2.z * b2.z + b2.w * b2.w);
                    v4u o; o.x = pk2(a.x, a.y); o.y = pk2(a.z, a.w); o.z = pk2(b2.x, b2.y); o.w = pk2(b2.z, b2.w);
                    *(GAS v4u*)(pan + pg8::atile_off(m & 255, g * 32 + c4 * 8)) = o; }
                s += shx(s, 1); s += shx(s, 2);
                if (c4 == 0) rowss[m] = pg8::rss_fix(s);
            } }
            { const float* mem = INP(1); const float* mem_norm_g = INP(13); bf16* MEMN = WSP(bf16, WS_MEMN);
            for (int m = gw; m < MMEM; m += NGW) {
                const GAS f32x4* xr = (const GAS f32x4*)(mem + (size_t)m * DM) + F.lane; f32x4 v[4]; float s = 0.f;
#pragma unroll
                for (int j = 0; j < 4; ++j) { v[j] = xr[64 * j]; s += (v[j].x * v[j].x + v[j].y * v[j].y) + (v[j].z * v[j].z + v[j].w * v[j].w); }
                const float r = 1.0f / sqrtf(wave_sum(s) * (1.0f / DM) + NORM_EPS);
                GAS v2u* o8 = (GAS v2u*)(MEMN + (size_t)m * DM) + F.lane;
#pragma unroll
                for (int j = 0; j < 4; ++j) { const f32x4 g = *((const f32x4*)mem_norm_g + F.lane + 64 * j); v2u w; w.x = pk2(v[j].x * r * g.x, v[j].y * r * g.y); w.y = pk2(v[j].z * r * g.z, v[j].w * r * g.w); o8[64 * j] = w; }
            } }
        } }
        if (!MK_PER_PHASE && 1 < args.ph_hi) xcd_barrier(bar, F.tid == 0);
    }
    for (int ph0 = (args.ph_lo > 1 ? args.ph_lo : 1); ph0 < args.ph_hi; ++ph0) {
      const int ptype = (ph0 == NPH - 1) ? 9 : 1 + (ph0 - 1) % 8; const int nrep = (ptype == PROBE_REP) ? 2 : 1;
      for (int rp = 0; rp < nrep; ++rp) {
        int ph = ph0; asm volatile("" : "+s"(ph));
#define PHASE_TID() do { unsigned ones_ = ~0u; asm volatile("" : "+s"(ones_)); int t_ = (wave0 << 6) | (int)__builtin_amdgcn_mbcnt_hi(ones_, __builtin_amdgcn_mbcnt_lo(ones_, 0u)); asm volatile("" : "+v"(t_)); F.tid = t_; F.lane = t_ & 63; } while (0)
        { F.wave = wave0; int bx_ = blockIdx.x, g_ = gridDim.x; asm volatile("" : "+s"(bx_), "+s"(g_)); F.G = g_; F.bx = bx_; F.vcu = (g_ % 8 == 0) ? (bx_ % 8) * (g_ / 8) + bx_ / 8 : bx_; }
        GAS unsigned char* wsb = (GAS unsigned char*)args.ws; asm volatile("" : "+s"(wsb));
        const int gw = F.vcu * NWAVES + F.wave, NGW = F.G * NWAVES;
        if (ph == NPH - 1) { { PHASE_TID();
            const pg8::rss_t* rs_fin = WSP(pg8::rss_t, WS_ROWSS) + (size_t)6 * MTOK; const float* final_g = INP(20); float* out = args.out;
            const bool dead = (!MK_PER_PHASE) && (xb_ld(WSP(unsigned, WS_CTL) + CW_BAR + XB_TMO) != 0u);
            { const int m = gw * 16 + (F.lane >> 2), c4 = F.lane & 3;
                const float r = pg8::rstd_of(rs_fin, m); const bf16* pan = WSP(bf16, WS_HB) + (size_t)(m >> 8) * 256 * DM; float* orow = out + (size_t)m * DM + c4 * 8;
#pragma unroll 8
                for (int g = 0; g < 32; ++g) { const v4u w = *(const GAS v4u*)(pan + pg8::atile_off(m & 255, g * 32 + c4 * 8));
                    const f32x4 g0 = *(const f32x4*)(final_g + g * 32 + c4 * 8), g1 = *(const f32x4*)(final_g + g * 32 + c4 * 8 + 4);
                    f32x4 v0 = (f32x4){bflo(w.x), bfhi(w.x), bflo(w.y), bfhi(w.y)} * r * g0, v1 = (f32x4){bflo(w.z), bfhi(w.z), bflo(w.w), bfhi(w.w)} * r * g1;
                    if (dead) { v0 = (f32x4){NAN, NAN, NAN, NAN}; v1 = v0; }
                    *(GAS f32x4*)(orow + g * 32) = v0; *(GAS f32x4*)(orow + g * 32 + 4) = v1; }
            }
        } } else {
            const int l = (ph - 1) / 8, j = (ph - 1) % 8;
            unsigned char* wl = (unsigned char*)(wsb + WS_W + (size_t)l * W_LAYER);
            pg8::rss_t* rowss = WSP(pg8::rss_t, WS_ROWSS);
            if (j == 0) { { PHASE_TID();
                pg8::ProbDense<true> S; S.A = WSP(bf16, WS_HB); S.Bt = (const bf16*)(wl + WO_IN); S.K = DM; S.lda = DM; S.ldb = DM; S.bbatch = 0; S.asliced = false; S.ord.init(MTOK / 256, INC / 256, F.G, F.bx, F.vcu);
                pg8::EpiIn E{WSP(bf16, WS_X + X_Q), WSP(bf16, WS_X + X_K), WSP(bf16, WS_X + X_V), WSP(bf16, WS_X + X_BG), WSP(bf16, WS_X + X_U), rowss + (size_t)(3 * l) * MTOK, WSP(float, WS_CS)};
                pg8::gemm_phase<pg8::EpiIn, pg8::ProbDense<true>, true, true>(F.lds + RING_OFF, S, E, F.tid);
                if (l == 0) {
                    pg8::ProbKV S2; S2.A = WSP(bf16, WS_MEMN); S2.Bt0 = WSP(bf16, WS_W + WO_KV); S2.lstride = W_LAYER / 2; S2.K = DM; S2.lda = DM; S2.ldb = DM; S2.G = F.G; S2.c = F.bx;
                    pg8::EpiKV E2{WSP(bf16, WS_KV), KV_LAYER / 2};
                    pg8::gemm_phase<pg8::EpiKV, pg8::ProbKV, true, true>(F.lds + RING_OFF, S2, E2, F.tid);
                }
            } } else if (j == 1) { { PHASE_TID();
                for (int bc = F.vcu; bc < NB * 16; bc += F.G) {
                    const int bhc = bc >> 1, b = bhc >> 3, hc = bhc & 7; const int cqk = hc * 64, cv = (hc >> 1) * 128, co = hc * 128;
                    for (int i = 0; i < 4; ++i) { const int qb = (bc & 1) ? ((0x7421 >> (4 * i)) & 15) : ((0x6530 >> (4 * i)) & 15);
                        attn_body::attn_unit128<8>(b, cqk, cv, co, qb, WSP(const attn_body::bf16, WS_X + X_Q), WSP(const attn_body::bf16, WS_X + X_K), WSP(const attn_body::bf16, WS_X + X_V), WSP(attn_body::bf16, WS_X + X_O), (char*)lds + RING_OFF, F.tid); }
                }
                const bf16* KVl = WSP(bf16, WS_KV) + (size_t)l * (KV_LAYER / 2);
                { pg8::ProbAbsorb S; S.A = KVl; S.Bt = (const bf16*)(wl + WO_QG); S.K = 256; S.lda = 2048; S.ldb = DM; S.a_b = (size_t)256 * 2048; S.a_h = 256; S.a_q = 0; S.b_b = 0; S.b_h = 256; S.b_q = (size_t)256 * DM; S.G = F.G; S.c = F.vcu;
                  pg8::EpiAbsorb E{WSP(bf16, WS_WQK), true};
                  pg8::gemm_phase<pg8::EpiAbsorb, pg8::ProbAbsorb, true, true>(F.lds + RING_OFF, S, E, F.tid); }
                { pg8::ProbAbsorb S; S.A = (const bf16*)(wl + WO_O); S.Bt = KVl + DM; S.K = 256; S.lda = DM; S.ldb = 2048; S.a_b = 0; S.a_h = 256; S.a_q = (size_t)256 * DM; S.b_b = (size_t)256 * 2048; S.b_h = 256; S.b_q = 0; S.G = F.G; S.c = F.vcu;
                  pg8::EpiAbsorb E{WSP(bf16, WS_VWO), false};
                  pg8::gemm_phase<pg8::EpiAbsorb, pg8::ProbAbsorb, true, true>(F.lds + RING_OFF, S, E, F.tid); }
            } } else if (j == 2) { { PHASE_TID();
                const float lambda_init = (l == 0) ? 0.2f : 0.35550906759f;
                const float d1 = wave_sum(INP(5)[l * 64 + F.lane] * INP(6)[l * 64 + F.lane]), d2 = wave_sum(INP(7)[l * 64 + F.lane] * INP(8)[l * 64 + F.lane]);
                const float lam = expf(d1) - expf(d2) + lambda_init;
                const int lane = F.lane, hh = lane >> 4, vhalf = (lane >> 3) & 1, dd = (lane & 7) * 8;
                const int c0col = (hh * 4 + vhalf) * 64 + dd, c1col = (hh * 4 + 2 + vhalf) * 64 + dd;
                const float* subln_g = INP(9); const float* conv_w = INP(10);
                const bf16* XO = WSP(bf16, WS_X + X_O); const bf16* XU = WSP(bf16, WS_X + X_U); const bf16* XBG = WSP(bf16, WS_X + X_BG); bf16* XMIX = WSP(bf16, WS_X + X_MIX);
                float sg[8], cw0[8], cw1[8], cw2[8];
#pragma unroll
                for (int jj = 0; jj < 8; ++jj) { sg[jj] = subln_g[l * 128 + (lane & 15) * 8 + jj] * (1.0f - lambda_init); cw0[jj] = conv_w[(l * 3 + 0) * 512 + lane * 8 + jj]; cw1[jj] = conv_w[(l * 3 + 1) * 512 + lane * 8 + jj]; cw2[jj] = conv_w[(l * 3 + 2) * 512 + lane * 8 + jj]; }
                for (int ch = gw; ch < MTOK / 16; ch += NGW) {
                    const int t0 = ch * 16; float u1[8], u2[8];
                    if ((t0 & (SEQ - 1)) == 0) {
#pragma unroll
                        for (int jj = 0; jj < 8; ++jj) { u1[jj] = 0.f; u2[jj] = 0.f; }
                    } else {
                        const v4u a = *(const v4u*)(XU + pg8::xrow(t0 - 1, 512) + lane * 8), b = *(const v4u*)(XU + pg8::xrow(t0 - 2, 512) + lane * 8);
                        u1[0] = bflo(a.x); u1[1] = bfhi(a.x); u1[2] = bflo(a.y); u1[3] = bfhi(a.y); u1[4] = bflo(a.z); u1[5] = bfhi(a.z); u1[6] = bflo(a.w); u1[7] = bfhi(a.w);
                        u2[0] = bflo(b.x); u2[1] = bfhi(b.x); u2[2] = bflo(b.y); u2[3] = bfhi(b.y); u2[4] = bflo(b.z); u2[5] = bfhi(b.z); u2[6] = bflo(b.w); u2[7] = bfhi(b.w);
                    }
#pragma unroll 4
                    for (int tt = 0; tt < 16; ++tt) { const size_t t5 = pg8::xrow(t0 + tt, 512), t = pg8::xrow(t0 + tt, 1024);
                        const v4u o0 = *(const v4u*)(XO + t + c0col), o1 = *(const v4u*)(XO + t + c1col), uu = *(const v4u*)(XU + t5 + lane * 8), bg = *(const v4u*)(XBG + t5 + lane * 8);
                        float d[8];
                        d[0] = bflo(o0.x) - lam * bflo(o1.x); d[1] = bfhi(o0.x) - lam * bfhi(o1.x); d[2] = bflo(o0.y) - lam * bflo(o1.y); d[3] = bfhi(o0.y) - lam * bfhi(o1.y);
                        d[4] = bflo(o0.z) - lam * bflo(o1.z); d[5] = bfhi(o0.z) - lam * bfhi(o1.z); d[6] = bflo(o0.w) - lam * bflo(o1.w); d[7] = bfhi(o0.w) - lam * bfhi(o1.w);
                        float ss = (d[0] * d[0] + d[1] * d[1]) + (d[2] * d[2] + d[3] * d[3]) + (d[4] * d[4] + d[5] * d[5]) + (d[6] * d[6] + d[7] * d[7]);
                        ss += shx(ss, 1); ss += shx(ss, 2); ss += shx(ss, 4); ss += shx(ss, 8);
                        const float r = __builtin_amdgcn_rsqf(ss * (1.0f / 128.0f) + SUBLN_EPS);
                        v4u oa; oa.x = pk2(d[0] * r * sg[0], d[1] * r * sg[1]); oa.y = pk2(d[2] * r * sg[2], d[3] * r * sg[3]); oa.z = pk2(d[4] * r * sg[4], d[5] * r * sg[5]); oa.w = pk2(d[6] * r * sg[6], d[7] * r * sg[7]);
                        float uc[8], bb[8], y[8];
                        uc[0] = bflo(uu.x); uc[1] = bfhi(uu.x); uc[2] = bflo(uu.y); uc[3] = bfhi(uu.y); uc[4] = bflo(uu.z); uc[5] = bfhi(uu.z); uc[6] = bflo(uu.w); uc[7] = bfhi(uu.w);
                        bb[0] = bflo(bg.x); bb[1] = bfhi(bg.x); bb[2] = bflo(bg.y); bb[3] = bfhi(bg.y); bb[4] = bflo(bg.z); bb[5] = bfhi(bg.z); bb[6] = bflo(bg.w); bb[7] = bfhi(bg.w);
#pragma unroll
                        for (int jj = 0; jj < 8; ++jj) { y[jj] = bb[jj] * (cw0[jj] * u2[jj] + cw1[jj] * u1[jj] + cw2[jj] * uc[jj]); u2[jj] = u1[jj]; u1[jj] = uc[jj]; }
                        v4u oc; oc.x = pk2(y[0], y[1]); oc.y = pk2(y[2], y[3]); oc.z = pk2(y[4], y[5]); oc.w = pk2(y[6], y[7]);
                        *(GAS v4u*)(XMIX + t + lane * 8) = oa; *(GAS v4u*)(XMIX + t + 512 + lane * 8) = oc; }
                }
            } } else if (j == 3) { { PHASE_TID();
                pg8::ProbDense<false> S; S.A = WSP(bf16, WS_X + X_MIX); S.Bt = (const bf16*)(wl + WO_MIX); S.K = DM; S.lda = DM; S.ldb = DM; S.bbatch = 0; S.asliced = true; S.ord.init(MTOK / 256, DM / 256, F.G, F.bx, F.vcu);
                pg8::EpiRes E{args.out, WSP(bf16, WS_HB), rowss + (size_t)(3 * l + 1) * MTOK, (rp == nrep - 1) ? 1.0f : 0.0f, rp == nrep - 1, (PG8_LAS float*)(F.lds + EPIX_OFF)};
                pg8::gemm_phase<pg8::EpiRes, pg8::ProbDense<false>, true, true>(F.lds + RING_OFF, S, E, F.tid);
            } } else if (j == 4) { { PHASE_TID();
                pg8::ProbDense<true> S; S.A = WSP(bf16, WS_HB); S.Bt = WSP(bf16, WS_WQK); S.K = DM; S.lda = DM; S.ldb = DM; S.bbatch = (size_t)DM * DM; S.asliced = false; S.ord.init(MTOK / 256, DM / 256, F.G, F.bx, F.vcu);
                pg8::EpiSoftmax E{WSP(bf16, WS_X + X_P), rowss + (size_t)(3 * l + 1) * MTOK, (PG8_LAS pg8::f32x2*)(F.lds + EPIX_OFF)};
                pg8::gemm_phase<pg8::EpiSoftmax, pg8::ProbDense<true>, true, true>(F.lds + RING_OFF, S, E, F.tid);
            } } else if (j == 5) { { PHASE_TID();
                pg8::ProbDense<true> S; S.A = WSP(bf16, WS_X + X_P); S.Bt = WSP(bf16, WS_VWO); S.K = DM; S.lda = DM; S.ldb = DM; S.bbatch = (size_t)DM * DM; S.asliced = true; S.ord.init(MTOK / 256, DM / 256, F.G, F.bx, F.vcu);
                pg8::EpiRes E{args.out, WSP(bf16, WS_HB), rowss + (size_t)(3 * l + 2) * MTOK, (rp == nrep - 1) ? 1.0f : 0.0f, rp == nrep - 1, (PG8_LAS float*)(F.lds + EPIX_OFF)};
                pg8::gemm_phase<pg8::EpiRes, pg8::ProbDense<true>, true, true>(F.lds + RING_OFF, S, E, F.tid);
            } } else if (j == 6) { { PHASE_TID();
                pg8::ProbDense<true> S; S.A = WSP(bf16, WS_HB); S.Bt = (const bf16*)(wl + WO_1); S.K = DM; S.lda = DM; S.ldb = DM; S.bbatch = 0; S.asliced = false; S.ord.init(MTOK / 256, FF / 256, F.G, F.bx, F.vcu);
                pg8::EpiRelu2 E{WSP(bf16, WS_X + X_F), rowss + (size_t)(3 * l + 2) * MTOK};
                pg8::gemm_phase<pg8::EpiRelu2, pg8::ProbDense<true>, true, true>(F.lds + RING_OFF, S, E, F.tid);
            } } else { { PHASE_TID();
                pg8::ProbDense<true> S; S.A = WSP(bf16, WS_X + X_F); S.Bt = (const bf16*)(wl + WO_2); S.K = FF; S.lda = FF; S.ldb = FF; S.bbatch = 0; S.asliced = true; S.ord.init(MTOK / 256, DM / 256, F.G, F.bx, F.vcu);
                pg8::EpiRes E{args.out, WSP(bf16, WS_HB), rowss + (size_t)(3 * l + 3) * MTOK, (rp == nrep - 1) ? 1.0f : 0.0f, rp == nrep - 1, (PG8_LAS float*)(F.lds + EPIX_OFF)};
                pg8::gemm_phase<pg8::EpiRes, pg8::ProbDense<true>, true, true>(F.lds + RING_OFF, S, E, F.tid);
            } }
        }
      }
        GAS unsigned char* wsb = (GAS unsigned char*)args.ws;
        if (!MK_PER_PHASE && ph0 + 1 < args.ph_hi) { bar.bar = WSP(unsigned, WS_CTL) + CW_BAR; unsigned on2_ = ~0u; asm volatile("" : "+s"(on2_)); const int ln_ = __builtin_amdgcn_mbcnt_hi(on2_, __builtin_amdgcn_mbcnt_lo(on2_, 0u)); const bool leader = (wave0 == 0 && ln_ == 0);
            if (ph0 == 1) {
                if (wave0 == 0) { const int bx_ = blockIdx.x; const unsigned mine = __hip_atomic_load(bar.bar + XB_XID(bx_), RLX_AGENT);
                    const unsigned other = (ln_ < 32) ? __hip_atomic_load(bar.bar + XB_XID((bx_ & 7) + 8 * ln_), RLX_AGENT) : mine;
                    const bool bad = (other != mine) || (mine == 0u) || ((gridDim.x & 7) != 0) || (gridDim.x != 256);
                    if (__any(bad) && ln_ == 0) __hip_atomic_store(bar.bar + XB_BAD, 1u, RLX_AGENT); }
                xcd_barrier(bar, leader);
                local_ok = (__hip_atomic_load(bar.bar + XB_BAD, RLX_AGENT) == 0u);
            } else if (local_ok) {
                const int js_ = (ph0 - 1) % 8; int vc_ = (blockIdx.x % 8) * 32 + blockIdx.x / 8; asm volatile("" : "+s"(vc_));
                if (js_ >= 3) pair_barrier(bar, leader, vc_ >> 2); else xcc_barrier(bar, leader);
            } else xcd_barrier(bar, leader); }
    }
}

extern "C" void kernel_launch(void* const* d_in, const int* in_sizes, int n_in, void* d_out, int out_size, void* d_ws, size_t ws_size, hipStream_t stream) {
    static int grid = 0;
    if (grid == 0) {
        if (n_in != 21 || in_sizes[0] != MTOK * DM || out_size != MTOK * DM || ws_size < WS_END) { fprintf(stderr, "kernel_launch: unexpected shapes (n_in %d, in0 %d, out %d, ws %zu); nothing launched\n", n_in, n_in > 0 ? in_sizes[0] : -1, out_size, ws_size); grid = -1; return; }
        int dev = 0, cus = 0, per_cu = 0;
        if (hipGetDevice(&dev) != hipSuccess || hipDeviceGetAttribute(&cus, hipDeviceAttributeMultiprocessorCount, dev) != hipSuccess) { grid = -1; return; }
        if (hipFuncSetAttribute((const void*)fwd_kernel, hipFuncAttributeMaxDynamicSharedMemorySize, LDS_BYTES) != hipSuccess) { fprintf(stderr, "kernel_launch: hipFuncSetAttribute failed\n"); grid = -1; return; }
        if (hipOccupancyMaxActiveBlocksPerMultiprocessor(&per_cu, (const void*)fwd_kernel, NWAVES * 64, LDS_BYTES) != hipSuccess || per_cu < 1) { fprintf(stderr, "kernel_launch: occupancy query reports %d blocks per CU\n", per_cu); }
        (void)hipGetLastError();
        grid = cus;
    }
    if (grid < 0) return;
    (void)hipMemsetAsync((char*)d_ws + WS_CTL, 0, CTL_ZERO_BYTES, stream);
    Args a{};
    for (int i = 0; i < 21; ++i) a.in[i] = d_in[i];
    a.out = (float*)d_out; a.ws = (unsigned char*)d_ws;
#if MK_PER_PHASE
    for (int p = 0; p < NPH; ++p) { a.ph_lo = p; a.ph_hi = p + 1; a.li = p; hipLaunchKernelGGL(fwd_kernel, dim3(grid), dim3(NWAVES * 64), LDS_BYTES, stream, a); }
#else
    a.ph_lo = 0; a.ph_hi = NPH; a.li = 0;
    hipLaunchKernelGGL(fwd_kernel, dim3(grid), dim3(NWAVES * 64), LDS_BYTES, stream, a);
#endif
}
```

```cpp
#include <hip/hip_runtime.h>
#include <hip/hip_bf16.h>
#include <cstdio>
#include <cstdint>
#include <cmath>

#ifndef RES_F32
#define RES_F32 0
#endif
static_assert(RES_F32 == 0, "the tiled residual layout is implemented for the bf16 residual only");
#ifndef MK_PER_PHASE
#define MK_PER_PHASE 0
#endif

constexpr int NB = 16, SEQ = 2048, DM = 1024, MTOK = NB * SEQ, MEML = 256, MMEM = NB * MEML, INC = 3072, FF = 4096, DEPTH = 2;
constexpr float NORM_EPS = 1e-6f, SUBLN_EPS = 1e-5f;
constexpr float LOG2E = 1.4426950408889634f;
constexpr float C2_ATT = 0.125f * LOG2E;
constexpr float C2_X = 0.0625f * LOG2E;

namespace pg8 {
#define PG8_LAS __attribute__((address_space(3)))
typedef unsigned short bf16_t;
typedef short bf16x8 __attribute__((ext_vector_type(8)));
typedef float f32x4 __attribute__((ext_vector_type(4)));
typedef float f32x2 __attribute__((ext_vector_type(2)));
typedef unsigned u32x4 __attribute__((ext_vector_type(4)));
constexpr int BM = 256, BK = 64, HALF = 128, HTB = HALF * BK * 2, STAGE_BYTES = 8 * HTB, NXCD = 8, WGM = 8;

__host__ __device__ __forceinline__ int lds_byte(int r, int c) { const int st = (r >> 4) * 2 + (c >> 5), rr = r & 15, cc = c & 31, ob = rr * 64 + cc * 2; return st * 1024 + (ob ^ (((ob >> 9) & 1) << 5)); }
__host__ __device__ __forceinline__ void stage_rc(int b, int& R, int& C) { const int st = b / 1024, sb = b % 1024, swz = sb ^ (((sb >> 9) & 1) << 5); R = (st >> 1) * 16 + swz / 64; C = (st & 1) * 32 + (swz % 64) / 2; }
__host__ __device__ __forceinline__ int perm32(int rho) { const int n = rho >> 4, i = rho & 15; return 8 * (i >> 2) + 4 * n + (i & 3); }

__host__ __device__ __forceinline__ int invperm32(int p) { return ((p >> 2) & 1) * 16 + (((p >> 3) << 2) | (p & 3)); }
__host__ __device__ __forceinline__ size_t btile_off(int n, int k, int K) {
    const int nt = n >> 8, half = (n >> 7) & 1, nl = n & 127, R = (nl & ~31) + invperm32(nl & 31), kt = k >> 6, C = k & 63;
    return ((size_t)(nt * (K >> 6) + kt) * 2 + half) * 8192 + (size_t)(lds_byte(R, C) >> 1);
}
__host__ __device__ __forceinline__ size_t atile_off(int r256, int k) { return ((size_t)(k >> 6) * 2 + (r256 >> 7)) * 8192 + (size_t)(lds_byte(r256 & 127, k & 63) >> 1); }
struct Unit { int pm, pn, z; };
typedef __attribute__((address_space(1))) unsigned char gbyte;
struct TileAddr { gbyte* b[2][2]; unsigned voff;
    __device__ __forceinline__ void init(void* panel, int pn, int wr, int wc, int fr, int fq) {
        gbyte* p = (gbyte*)panel + (size_t)__builtin_amdgcn_readfirstlane(pn) * 131072;
        b[0][0] = p; b[1][0] = p + 16384; b[0][1] = p + 65536; b[1][1] = p + 81920;
        asm volatile("" : "+s"(b[0][0]), "+s"(b[1][0]), "+s"(b[0][1]), "+s"(b[1][1]));
        voff = (unsigned)((wc >> 1) * 32768 + lds_byte(wr * 64 + fr, (wc & 1) * 32 + 8 * fq) + 4096); }
    __device__ __forceinline__ __attribute__((address_space(1))) u32x4* at(int ai, int bj, int m) const { return (__attribute__((address_space(1))) u32x4*)(b[ai][bj] + (size_t)voff + (m - 2) * 2048); }
};
constexpr size_t XG_EL = (size_t)16 << 20;
constexpr size_t XP_EL = (size_t)1 << 20;
__device__ __forceinline__ size_t xrow(int row, int ld) { return (size_t)(row >> 8) * XP_EL + (size_t)(row & 255) * ld; }

struct Order2D {
    int nM, nN, nwg, G, c, vcu; bool pair;
    __device__ __forceinline__ void init(int nM_, int nN_, int G_, int c_, int vcu_) { nM = nM_; nN = nN_; nwg = nM * nN; G = G_; c = c_; vcu = vcu_; pair = (G_ == 256) && (nM_ == 128) && ((nN_ & 3) == 0); }
    __device__ __forceinline__ bool next(int i, int& pm, int& pn) const {
        if (pair) { const int per = nN >> 2; if (i >= 2 * per) return false; const int sel = (i >= per) ? 1 : 0; pm = 2 * (vcu >> 2) + sel; pn = 4 * (i - sel * per) + (vcu & 3); return true; }
        const long L = (long)i * G + c; if (L >= nwg) return false;
        int wgid = (int)L; { const int q = nwg / NXCD, r = nwg % NXCD, xcd = wgid % NXCD, off = wgid / NXCD; wgid = (xcd < r ? xcd * (q + 1) : r * (q + 1) + (xcd - r) * q) + off; }
        const int nig = WGM * nN, gid = wgid / nig, fm = gid * WGM, gsz = (nM - fm) < WGM ? (nM - fm) : WGM;
        pm = fm + ((wgid % nig) % gsz); pn = (wgid % nig) / gsz; return true;
    }
};

__device__ __forceinline__ unsigned cvt_pk_bf16(float lo, float hi) { unsigned r; asm volatile("v_cvt_pk_bf16_f32 %0, %1, %2" : "=v"(r) : "v"(lo), "v"(hi)); return r; }

template <class Epi, class Prob, bool ALIGN_EPI, bool SP2>
__device__ __forceinline__ void gemm_phase(PG8_LAS unsigned char* lds, const Prob& S, const Epi& E, const int tid) {
    const int wid = __builtin_amdgcn_readfirstlane(tid >> 6), lane = tid & 63, wr = wid >> 2, wc = wid & 3, fr = lane & 15, fq = lane >> 4;
    const int K = S.K, nt = K / BK;
    unsigned voffA[2], voffB[2];
#pragma unroll
    for (int i = 0; i < 2; ++i) { int R, C; stage_rc(tid * 16 + i * 8192, R, C); const int Rb = (R & ~31) + perm32(R & 31);
        voffA[i] = Prob::ATILED ? (unsigned)(tid * 16 + i * 8192) : (unsigned)(R * S.lda + C) * 2u; voffB[i] = Prob::BTILED ? (unsigned)(tid * 16 + i * 8192) : (unsigned)(Rb * S.ldb + C) * 2u; }
    const size_t kstep = Prob::ATILED ? (size_t)32768 : (size_t)(BK * 2), kstepB = Prob::BTILED ? (size_t)32768 : (size_t)(BK * 2);
    const size_t hstepA = Prob::ATILED ? (size_t)16384 : (size_t)HALF * S.lda * 2, hstepB = Prob::BTILED ? (size_t)16384 : (size_t)HALF * S.ldb * 2;
    const unsigned ldsw = (unsigned)wid * 1024u;
    const int aoff = lds_byte(wr * 64 + fr, fq * 8), boff = lds_byte(wc * 32 + fr, fq * 8);
#define PG8_SA(b, h) (((b) * 2 + (h)) * HTB)
#define PG8_SB(b, h) ((4 + (b) * 2 + (h)) * HTB)
#define PG8_STAGE(bufoff, gbase, voff) do { _Pragma("unroll") for (int _i = 0; _i < 2; ++_i) \
        __builtin_amdgcn_global_load_lds((const unsigned*)((const char*)(gbase) + (voff)[_i]), (PG8_LAS unsigned*)(lds + (bufoff) + ldsw + _i * 8192), 16, 0, 0); } while (0)
#define PG8_LDA(dst, b, h) do { _Pragma("unroll") for (int m = 0; m < 4; ++m) _Pragma("unroll") for (int k = 0; k < 2; ++k) dst[m][k] = *(const PG8_LAS bf16x8*)(lds + PG8_SA(b, h) + aoff + m * 2048 + k * 1024); } while (0)
#define PG8_LDB(dst, b, h) do { _Pragma("unroll") for (int n = 0; n < 2; ++n) _Pragma("unroll") for (int k = 0; k < 2; ++k) dst[n][k] = *(const PG8_LAS bf16x8*)(lds + PG8_SB(b, h) + boff + n * 2048 + k * 1024); } while (0)
#define PG8_MMA(ai, bj, At, Bt) do { __builtin_amdgcn_s_setprio(1); _Pragma("unroll") for (int m = 0; m < 4; ++m) _Pragma("unroll") for (int n = 0; n < 2; ++n) _Pragma("unroll") for (int k = 0; k < 2; ++k) \
        acc[ai][bj][m][n] = __builtin_amdgcn_mfma_f32_16x16x32_bf16(Bt[n][k], At[m][k], acc[ai][bj][m][n], 0, 0, 0); __builtin_amdgcn_s_setprio(0); } while (0)
#define PG8_WAIT_V(n) asm volatile("s_waitcnt vmcnt(" #n ")" ::: "memory")
#define PG8_WAIT_L(n) asm volatile("s_waitcnt lgkmcnt(" #n ")" ::: "memory")
#define PG8_BAR __builtin_amdgcn_s_barrier()
#define PG8_SCHED __builtin_amdgcn_sched_barrier(0)
    Unit cur, nxt; int ui = 0;
    if (!S.next(0, cur)) return;
    typename Epi::Pre pre; E.init(pre); E.prefetch(pre, cur, wr, fr);
    f32x4 acc[2][2][4][2];
#pragma unroll
    for (int a = 0; a < 2; ++a)
#pragma unroll
        for (int b = 0; b < 2; ++b)
#pragma unroll
            for (int m = 0; m < 4; ++m)
#pragma unroll
                for (int n = 0; n < 2; ++n) acc[a][b][m][n] = (f32x4){0.f, 0.f, 0.f, 0.f};
    bf16x8 At[4][2], B0[2][2], B1[2][2];
    const char* cA = S.aptr(cur); const char* cB = S.bptr(cur);
    if constexpr (SP2) {
        PG8_STAGE(PG8_SB(0, 0), cB, voffB); PG8_STAGE(PG8_SB(0, 1), cB + hstepB, voffB); PG8_STAGE(PG8_SA(0, 0), cA, voffA); PG8_STAGE(PG8_SA(0, 1), cA + hstepA, voffA);
        if (wr == 1) PG8_BAR;
        PG8_WAIT_V(2); PG8_BAR;
        PG8_STAGE(PG8_SB(1, 0), cB + kstepB, voffB); PG8_STAGE(PG8_SA(1, 0), cA + kstep, voffA); PG8_STAGE(PG8_SB(1, 1), cB + hstepB + kstepB, voffB);
        PG8_WAIT_V(6); PG8_BAR;
    } else {
        PG8_STAGE(PG8_SB(0, 0), cB, voffB); PG8_STAGE(PG8_SA(0, 0), cA, voffA); PG8_STAGE(PG8_SB(0, 1), cB + hstepB, voffB); PG8_STAGE(PG8_SA(0, 1), cA + hstepA, voffA);
        if (wr == 1) PG8_BAR;
        PG8_WAIT_V(4); PG8_BAR;
        PG8_STAGE(PG8_SB(1, 0), cB + kstepB, voffB); PG8_STAGE(PG8_SA(1, 0), cA + kstep, voffA); PG8_STAGE(PG8_SB(1, 1), cB + hstepB + kstepB, voffB);
        PG8_WAIT_V(6); PG8_BAR;
    }
    for (;;) {
        const bool has_next = S.next(ui + 1, nxt);
        const char* nA = has_next ? S.aptr(nxt) : cA; const char* nB = has_next ? S.bptr(nxt) : cB;
        for (int t = 0; t < nt; t += 2) {
            const bool last = (t == nt - 2);
            const char* a1 = cA + (size_t)(t + 1) * kstep;
            const char* a2 = last ? nA : cA + (size_t)(t + 2) * kstep; const char* b2 = last ? nB : cB + (size_t)(t + 2) * kstepB;
            const char* a3 = a2 + kstep; const char* b3 = b2 + kstepB;
            if constexpr (SP2) {
            PG8_LDB(B0, 0, 0); PG8_LDB(B1, 0, 1); PG8_SCHED; PG8_LDA(At, 0, 0); PG8_STAGE(PG8_SA(1, 1), a1 + hstepA, voffA);
            PG8_WAIT_V(8); PG8_WAIT_L(0); PG8_BAR; PG8_MMA(0, 0, At, B0); PG8_MMA(0, 1, At, B1); PG8_BAR; PG8_SCHED;
            PG8_LDA(At, 0, 1); PG8_STAGE(PG8_SB(0, 0), b2, voffB); PG8_STAGE(PG8_SB(0, 1), b2 + hstepB, voffB); PG8_STAGE(PG8_SA(0, 0), a2, voffA);
            PG8_WAIT_V(8); PG8_WAIT_L(0); PG8_BAR; PG8_MMA(1, 0, At, B0); PG8_MMA(1, 1, At, B1); PG8_BAR; PG8_SCHED;
            PG8_LDB(B0, 1, 0); PG8_LDB(B1, 1, 1); PG8_SCHED; PG8_LDA(At, 1, 0); PG8_STAGE(PG8_SA(0, 1), a2 + hstepA, voffA);
            PG8_WAIT_V(8); PG8_WAIT_L(0); PG8_BAR; PG8_MMA(0, 0, At, B0); PG8_MMA(0, 1, At, B1); PG8_BAR; PG8_SCHED;
            PG8_LDA(At, 1, 1); PG8_STAGE(PG8_SB(1, 0), b3, voffB); PG8_STAGE(PG8_SB(1, 1), b3 + hstepB, voffB); PG8_STAGE(PG8_SA(1, 0), a3, voffA);
            PG8_WAIT_V(8); PG8_WAIT_L(0); PG8_BAR; PG8_MMA(1, 0, At, B0); PG8_MMA(1, 1, At, B1); PG8_BAR; PG8_SCHED;
            } else {
            PG8_LDB(B0, 0, 0); PG8_SCHED; PG8_LDA(At, 0, 0); PG8_STAGE(PG8_SA(1, 1), a1 + hstepA, voffA);
            PG8_WAIT_L(8); PG8_BAR; PG8_WAIT_L(0); PG8_MMA(0, 0, At, B0); PG8_BAR; PG8_SCHED;
            PG8_LDB(B1, 0, 1); PG8_STAGE(PG8_SB(0, 0), b2, voffB);
            PG8_BAR; PG8_WAIT_L(0); PG8_MMA(0, 1, At, B1); PG8_BAR;
            PG8_LDA(At, 0, 1); PG8_STAGE(PG8_SA(0, 0), a2, voffA);
            PG8_BAR; PG8_WAIT_L(0); PG8_MMA(1, 0, At, B0); PG8_BAR; PG8_SCHED;
            PG8_STAGE(PG8_SB(0, 1), b2 + hstepB, voffB);
            PG8_WAIT_V(6); PG8_BAR; PG8_MMA(1, 1, At, B1); PG8_BAR;
            PG8_LDB(B0, 1, 0); PG8_SCHED; PG8_LDA(At, 1, 0); PG8_STAGE(PG8_SA(0, 1), a2 + hstepA, voffA);
            PG8_WAIT_L(8); PG8_BAR; PG8_WAIT_L(0); PG8_MMA(0, 0, At, B0); PG8_BAR; PG8_SCHED;
            PG8_LDB(B1, 1, 1); PG8_STAGE(PG8_SB(1, 0), b3, voffB);
            PG8_BAR; PG8_WAIT_L(0); PG8_MMA(0, 1, At, B1); PG8_BAR;
            PG8_LDA(At, 1, 1); PG8_STAGE(PG8_SA(1, 0), a3, voffA);
            PG8_BAR; PG8_WAIT_L(0); PG8_MMA(1, 0, At, B0); PG8_BAR; PG8_SCHED;
            PG8_STAGE(PG8_SB(1, 1), b3 + hstepB, voffB);
            PG8_WAIT_V(6); PG8_BAR; PG8_MMA(1, 1, At, B1); PG8_BAR;
            }
        }
        if constexpr (ALIGN_EPI) { if (wr == 0) PG8_BAR; }
        { unsigned on_ = ~0u; asm volatile("" : "+s"(on_)); const int ln_ = (int)__builtin_amdgcn_mbcnt_hi(on_, __builtin_amdgcn_mbcnt_lo(on_, 0u)); int fr_ = ln_ & 15, fq_ = ln_ >> 4; asm volatile("" : "+v"(fr_), "+v"(fq_));
          E(acc, cur, wr, wc, fr_, fq_, pre); }
        if (!has_next) break;
#pragma unroll
        for (int a = 0; a < 2; ++a)
#pragma unroll
            for (int b = 0; b < 2; ++b)
#pragma unroll
                for (int m = 0; m < 4; ++m)
#pragma unroll
                    for (int n = 0; n < 2; ++n) acc[a][b][m][n] = (f32x4){0.f, 0.f, 0.f, 0.f};
        cur = nxt; cA = nA; cB = nB; ++ui;
        E.prefetch(pre, cur, wr, fr);
        if constexpr (ALIGN_EPI) { if (wr == 1) PG8_BAR; }
    }
    PG8_WAIT_V(0);
    if constexpr (!ALIGN_EPI) { if (wr == 0) PG8_BAR; }
    PG8_BAR;
    E.finish(pre, wid, lane);
#undef PG8_SA
#undef PG8_SB
#undef PG8_STAGE
#undef PG8_LDA
#undef PG8_LDB
#undef PG8_MMA
#undef PG8_WAIT_V
#undef PG8_WAIT_L
#undef PG8_BAR
#undef PG8_SCHED
}

template <bool ATILED_> struct ProbDense {
    static constexpr bool BTILED = true, ATILED = ATILED_;
    const bf16_t* A; const bf16_t* Bt; int K, lda, ldb; size_t bbatch; Order2D ord; bool asliced;
    __device__ __forceinline__ bool next(int i, Unit& u) const { u.z = 0; return ord.next(i, u.pm, u.pn); }
    __device__ __forceinline__ const char* aptr(const Unit& u) const { return (const char*)(A + (asliced ? xrow(u.pm * BM, lda) : (size_t)u.pm * BM * lda)); }
    __device__ __forceinline__ const char* bptr(const Unit& u) const { return (const char*)(Bt + (size_t)(u.pm >> 3) * bbatch + (size_t)u.pn * BM * ldb); }
};
struct ProbKV {
    static constexpr bool BTILED = true, ATILED = false;
    const bf16_t* A; const bf16_t* Bt0; size_t lstride; int K, lda, ldb; int G, c;
    __device__ __forceinline__ bool next(int i, Unit& u) const { const int L = i * G + c; if (L >= 256) return false; const int g = L & 7, k = L >> 3; u.z = 0; u.pm = 2 * g + (k >> 4); u.pn = k & 15; return true; }
    __device__ __forceinline__ const char* aptr(const Unit& u) const { return (const char*)(A + (size_t)u.pm * BM * lda); }
    __device__ __forceinline__ const char* bptr(const Unit& u) const { return (const char*)(Bt0 + (size_t)(u.pn >> 3) * lstride + (size_t)(u.pn & 7) * BM * ldb); }
};
struct ProbAbsorb {
    static constexpr bool BTILED = false, ATILED = false;
    const bf16_t *Kp, *Vp, *Wq, *Wo; int K, lda, ldb; int G, c;
    __device__ __forceinline__ bool next(int i, Unit& u) const { const int L = i * G + c; if (L >= 512) return false; const int l2 = L & 255; u.pn = l2 & 3; u.pm = (l2 >> 2) & 3; u.z = (l2 >> 4) | ((L >> 8) << 8); return true; }
    __device__ __forceinline__ const char* aptr(const Unit& u) const { const int b = u.z & 255; return (const char*)((u.z >> 8) ? Wo + (size_t)u.pm * 256 + (size_t)u.pn * (256 * 1024) : Kp + (size_t)b * (256 * 1024) + (size_t)u.pm * 256); }
    __device__ __forceinline__ const char* bptr(const Unit& u) const { const int b = u.z & 255; return (const char*)((u.z >> 8) ? Vp + (size_t)b * (256 * 1024) + (size_t)u.pm * 256 : Wq + (size_t)u.pm * 256 + (size_t)u.pn * (256 * 1024)); }
};

__device__ __forceinline__ u32x4 pack8(const f32x4 v0, const f32x4 v1) { u32x4 w; w.x = cvt_pk_bf16(v0[0], v0[1]); w.y = cvt_pk_bf16(v0[2], v0[3]); w.z = cvt_pk_bf16(v1[0], v1[1]); w.w = cvt_pk_bf16(v1[2], v1[3]); return w; }

__device__ __forceinline__ float xor16(float x, bool odd_row) { const unsigned u = __float_as_uint(x); auto r = __builtin_amdgcn_permlane16_swap(u, u, false, false); return __uint_as_float(odd_row ? r[0] : r[1]); }
__device__ __forceinline__ float quad_sum(float x) {
    { const unsigned u = __float_as_uint(x); auto r = __builtin_amdgcn_permlane16_swap(u, u, false, false); x = __uint_as_float(r[0]) + __uint_as_float(r[1]); }
    { const unsigned u = __float_as_uint(x); auto r = __builtin_amdgcn_permlane32_swap(u, u, false, false); x = __uint_as_float(r[0]) + __uint_as_float(r[1]); }
    return x;
}
__device__ __forceinline__ float quad_max(float x) {
    { const unsigned u = __float_as_uint(x); auto r = __builtin_amdgcn_permlane16_swap(u, u, false, false); x = fmaxf(__uint_as_float(r[0]), __uint_as_float(r[1])); }
    { const unsigned u = __float_as_uint(x); auto r = __builtin_amdgcn_permlane32_swap(u, u, false, false); x = fmaxf(__uint_as_float(r[0]), __uint_as_float(r[1])); }
    return x;
}
struct PreNone {};
struct EpiKV {
    bf16_t* O; size_t lstride;
    typedef PreNone Pre; __device__ __forceinline__ void init(Pre&) const {} __device__ __forceinline__ void finish(Pre&, int, int) const {} __device__ __forceinline__ void prefetch(Pre&, const Unit&, int, int) const {}
    __device__ __forceinline__ void operator()(f32x4 (&acc)[2][2][4][2], const Unit& u, int wr, int wc, int fr, int fq, const Pre&) const {
        bf16_t* base = O + (size_t)(u.pn >> 3) * lstride + (size_t)((u.pn & 7) >> 2) * ((size_t)4096 * 1024) + (size_t)(u.pm * BM + wr * 64 + fr) * 1024 + (u.pn & 3) * BM + wc * 32 + 8 * fq;
#pragma unroll
        for (int ai = 0; ai < 2; ++ai)
#pragma unroll
            for (int m = 0; m < 4; ++m) { bf16_t* rowp = base + (size_t)(ai * HALF + m * 16) * 1024;
#pragma unroll
                for (int bj = 0; bj < 2; ++bj) *(u32x4*)(rowp + bj * HALF) = pack8(acc[ai][bj][m][0], acc[ai][bj][m][1]); }
    }
};
struct EpiAbsorb {
    bf16_t *Owqk, *Ovwo;
    typedef PreNone Pre; __device__ __forceinline__ void init(Pre&) const {} __device__ __forceinline__ void finish(Pre&, int, int) const {} __device__ __forceinline__ void prefetch(Pre&, const Unit&, int, int) const {}
    __device__ __forceinline__ void operator()(f32x4 (&acc)[2][2][4][2], const Unit& u, int wr, int wc, int fr, int fq, const Pre&) const {
        const bool rows_by_h = (u.z >> 8) == 0; bf16_t* base = (rows_by_h ? Owqk : Ovwo) + (size_t)(u.z & 255) * ((size_t)1024 * 1024);
        const int n0 = (rows_by_h ? u.pm : u.pn) * 256 + wr * 64 + fr, k0 = (rows_by_h ? u.pn : u.pm) * 256 + wc * 32 + 8 * fq;
#pragma unroll
        for (int ai = 0; ai < 2; ++ai)
#pragma unroll
            for (int m = 0; m < 4; ++m)
#pragma unroll
                for (int bj = 0; bj < 2; ++bj) *(u32x4*)(base + btile_off(n0 + ai * HALF + m * 16, k0 + bj * HALF, 1024)) = pack8(acc[ai][bj][m][0], acc[ai][bj][m][1]);
    }
};
typedef unsigned long long rss_t;
constexpr float RSS_SCALE = 1048576.0f, RSS_INV = 1.0f / 1048576.0f;
__device__ __forceinline__ float rss_val(const rss_t* rowss, int row) { const rss_t v = rowss[row]; return ((float)(unsigned)(v >> 32) * 4096.0f + (float)(unsigned)v * RSS_INV); }
__device__ __forceinline__ rss_t rss_fix(float ss) { return (rss_t)(ss * RSS_SCALE + 0.5f); }
__device__ __forceinline__ float rstd_of(const rss_t* rowss, int row) { return __builtin_amdgcn_rsqf(rss_val(rowss, row) * (1.0f / 1024.0f) + NORM_EPS); }

struct PreRss { rss_t v[2][4]; };
__device__ __forceinline__ void rss_prefetch(PreRss& p, const rss_t* rowss, int row0) {
#pragma unroll
    for (int ai = 0; ai < 2; ++ai)
#pragma unroll
        for (int m = 0; m < 4; ++m) p.v[ai][m] = rowss[row0 + ai * HALF + m * 16];
}
__device__ __forceinline__ void rstd8(float (&r)[2][4], const PreRss& p, float sc) {
    const rss_t (&v)[2][4] = p.v;
#pragma unroll
    for (int ai = 0; ai < 2; ++ai)
#pragma unroll
        for (int m = 0; m < 4; ++m) r[ai][m] = __builtin_amdgcn_rsqf(((float)(unsigned)(v[ai][m] >> 32) * 4096.0f + (float)(unsigned)v[ai][m] * RSS_INV) * (1.0f / 1024.0f) + NORM_EPS) * sc;
}
struct EpiIn {
    bf16_t *Q, *Kb, *V, *Bg, *U; const rss_t* rowss; const float* cs; bf16_t* Halo;
    typedef PreRss Pre; __device__ __forceinline__ void init(Pre&) const {} __device__ __forceinline__ void finish(Pre&, int, int) const {} __device__ __forceinline__ void prefetch(Pre& p, const Unit& u, int wr, int fr) const { rss_prefetch(p, rowss, u.pm * BM + wr * 64 + fr); }
    __device__ __forceinline__ void operator()(f32x4 (&acc)[2][2][4][2], const Unit& u, int wr, int wc, int fr, int fq, const Pre& pre) const {
        const int pn = u.pn; const int row0 = u.pm * BM + wr * 64 + fr, colw = wc * 32 + 8 * fq;
        float r[2][4];
        if (pn < 4) {
            bf16_t* dst = (pn < 2 ? Q : Kb) + xrow(row0, 512) + (pn & 1) * 256 + colw;
            rstd8(r, pre, pn < 2 ? C2_ATT : 1.0f);
            const bool rotw = (wc & 1) == 0; const float sgn = fq == 0 ? -1.0f : 1.0f; const bool rotl = fq < 2;
            if (rotw) {
                const f32x4* cp = (const f32x4*)(cs + (size_t)row0 * 16); f32x4 nc0 = cp[0], nc1 = cp[1], ns0 = cp[2], ns1 = cp[3];
#pragma unroll
                for (int i = 0; i < 8; ++i) { const int ai = i >> 2, m = i & 3; const f32x4 c0 = nc0, c1 = nc1, s0 = ns0, s1 = ns1;
                    if (i < 7) { const int i2 = i + 1; const f32x4* cq = (const f32x4*)(cs + (size_t)(row0 + (i2 >> 2) * HALF + (i2 & 3) * 16) * 16); nc0 = cq[0]; nc1 = cq[1]; ns0 = cq[2]; ns1 = cq[3]; }
#pragma unroll
                    for (int bj = 0; bj < 2; ++bj) { f32x4 v0 = acc[ai][bj][m][0] * r[ai][m], v1 = acc[ai][bj][m][1] * r[ai][m], o0, o1;
#pragma unroll
                        for (int j = 0; j < 4; ++j) { o0[j] = xor16(v0[j], (fq & 1) != 0); o1[j] = xor16(v1[j], (fq & 1) != 0); }
                        if (rotl) { v0 = v0 * c0 + o0 * s0 * sgn; v1 = v1 * c1 + o1 * s1 * sgn; }
                        *(u32x4*)(dst + (size_t)(ai * HALF + m * 16) * 512 + bj * HALF) = pack8(v0, v1); }
                    asm volatile("" ::: "memory"); }
            } else {
#pragma unroll
                for (int ai = 0; ai < 2; ++ai)
#pragma unroll
                    for (int m = 0; m < 4; ++m)
#pragma unroll
                        for (int bj = 0; bj < 2; ++bj) *(u32x4*)(dst + (size_t)(ai * HALF + m * 16) * 512 + bj * HALF) = pack8(acc[ai][bj][m][0] * r[ai][m], acc[ai][bj][m][1] * r[ai][m]);
            }
        } else if (pn < 8) {
            bf16_t* dst = (pn < 6 ? V : Bg) + xrow(row0, 512) + (pn & 1) * 256 + colw;
            rstd8(r, pre, 1.0f);
#pragma unroll
            for (int ai = 0; ai < 2; ++ai)
#pragma unroll
                for (int m = 0; m < 4; ++m)
#pragma unroll
                    for (int bj = 0; bj < 2; ++bj) *(u32x4*)(dst + (size_t)(ai * HALF + m * 16) * 512 + bj * HALF) = pack8(acc[ai][bj][m][0] * r[ai][m], acc[ai][bj][m][1] * r[ai][m]);
        } else {
            bf16_t* dst = U + xrow(row0, 512) + (pn - 8) * 128 + colw;
            rstd8(r, pre, 1.0f);
#pragma unroll
            for (int ai = 0; ai < 2; ++ai)
#pragma unroll
                for (int m = 0; m < 4; ++m) { const float r2 = r[ai][m] * r[ai][m];
                    const u32x4 w = pack8(acc[ai][0][m][0] * acc[ai][1][m][0] * r2, acc[ai][0][m][1] * acc[ai][1][m][1] * r2);
                    *(u32x4*)(dst + (size_t)(ai * HALF + m * 16) * 512) = w;
                    if (ai == 1 && m == 3) { if (wr == 1 && fr >= 14) *(u32x4*)(Halo + ((size_t)u.pm * 2 + (fr - 14)) * 512 + (pn - 8) * 128 + colw) = w; } }
        }
    }
};
struct EpiRes {
    float* H32; bf16_t* HB; rss_t* rowss_out; float scale; bool do_ss; PG8_LAS float* X;
    struct Pre { int prev_pm, buf; };
    __device__ __forceinline__ void init(Pre& p) const { p.prev_pm = -1; p.buf = 0; }
    __device__ __forceinline__ void prefetch(Pre&, const Unit&, int, int) const {}
    __device__ __forceinline__ void flush(int pm, int bufsel, int wv, int ln) const {
        if (ln < 32 && do_ss) { const int rl = wv * 32 + ln; const f32x4 p4 = *(const PG8_LAS f32x4*)(X + bufsel * 1024 + rl * 4);
            atomicAdd(rowss_out + pm * BM + rl, rss_fix((p4[0] + p4[1]) + (p4[2] + p4[3]))); } }
    __device__ __forceinline__ void finish(Pre& p, int wv, int ln) const { if (p.prev_pm >= 0) flush(p.prev_pm, p.buf ^ 1, wv, ln); }
    __device__ __forceinline__ void operator()(f32x4 (&acc)[2][2][4][2], const Unit& u, int wr, int wc, int fr, int fq, Pre& pst) const {
        const int row0 = u.pm * BM + wr * 64 + fr, col0 = u.pn * BM + wc * 32 + 8 * fq;
#if RES_F32
#pragma unroll
        for (int ai = 0; ai < 2; ++ai)
#pragma unroll
            for (int m = 0; m < 4; ++m) { const int row = row0 + ai * HALF + m * 16; float ss = 0.f;
#pragma unroll
                for (int bj = 0; bj < 2; ++bj) { const size_t off = (size_t)row * 1024 + col0 + bj * HALF; f32x4 v0, v1;
                    v0 = *(const f32x4*)(H32 + off); v1 = *(const f32x4*)(H32 + off + 4);
                    v0 = v0 + acc[ai][bj][m][0] * scale; v1 = v1 + acc[ai][bj][m][1] * scale;
                    *(f32x4*)(H32 + off) = v0; *(f32x4*)(H32 + off + 4) = v1;
                    *(u32x4*)(HB + off) = pack8(v0, v1);
                    ss += (v0[0] * v0[0] + v0[1] * v0[1]) + (v0[2] * v0[2] + v0[3] * v0[3]) + (v1[0] * v1[0] + v1[1] * v1[1]) + (v1[2] * v1[2] + v1[3] * v1[3]); }
                ss = quad_sum(ss);
                if (fq == 0 && do_ss) atomicAdd(rowss_out + row, rss_fix(ss));
                if (m & 1) asm volatile("" ::: "memory"); }
#else
        TileAddr ta; ta.init(HB + (size_t)__builtin_amdgcn_readfirstlane(u.pm) * (BM * 1024), u.pn, wr, wc, fr, fq);
#define HBP(ai_, bj_, m_) ta.at(ai_, bj_, m_)
        u32x4 old[8][2];
#pragma unroll
        for (int i = 0; i < 8; ++i) { old[i][0] = *HBP(i >> 2, 0, i & 3); old[i][1] = *HBP(i >> 2, 1, i & 3); }
#pragma unroll
        for (int i = 0; i < 8; ++i) { const int ai = i >> 2, m = i & 3;
            f32x2 s2 = (f32x2){0.f, 0.f};
#pragma unroll
            for (int bj = 0; bj < 2; ++bj) { const u32x4 hw = old[i][bj];
                f32x4 v0 = (f32x4){__uint_as_float(hw.x << 16), __uint_as_float(hw.x & 0xffff0000u), __uint_as_float(hw.y << 16), __uint_as_float(hw.y & 0xffff0000u)};
                f32x4 v1 = (f32x4){__uint_as_float(hw.z << 16), __uint_as_float(hw.z & 0xffff0000u), __uint_as_float(hw.w << 16), __uint_as_float(hw.w & 0xffff0000u)};
                v0 = v0 + acc[ai][bj][m][0] * scale; v1 = v1 + acc[ai][bj][m][1] * scale;
                *HBP(ai, bj, m) = pack8(v0, v1);
                const f32x2 p0 = (f32x2){v0[0], v0[1]}, p1 = (f32x2){v0[2], v0[3]}, p2 = (f32x2){v1[0], v1[1]}, p3 = (f32x2){v1[2], v1[3]};
                s2 = s2 + p0 * p0; s2 = s2 + p1 * p1; s2 = s2 + p2 * p2; s2 = s2 + p3 * p3; }
            float ss = s2[0] + s2[1];
            ss = quad_sum(ss);
            if (fq == 0) X[pst.buf * 1024 + (ai * HALF + wr * 64 + m * 16 + fr) * 4 + wc] = ss; }
        { const int wv = wr * 4 + wc; int ln = fq * 16 + fr; asm volatile("" : "+v"(ln));
          if (pst.prev_pm >= 0) flush(pst.prev_pm, pst.buf ^ 1, wv, ln);
          pst.prev_pm = u.pm; pst.buf ^= 1; }
        asm volatile("s_waitcnt lgkmcnt(0)" ::: "memory");
#undef HBP
#endif
    }
};
struct EpiSoftmax {
    bf16_t* P; const rss_t* rowss; PG8_LAS f32x2* X;
    typedef PreRss Pre; __device__ __forceinline__ void init(Pre&) const {} __device__ __forceinline__ void finish(Pre&, int, int) const {} __device__ __forceinline__ void prefetch(Pre& p, const Unit& u, int wr, int fr) const { rss_prefetch(p, rowss, u.pm * BM + wr * 64 + fr); }
    __device__ __forceinline__ void operator()(f32x4 (&acc)[2][2][4][2], const Unit& u, int wr, int wc, int fr, int fq, const Pre& pre) const {
        const int row0 = u.pm * BM + wr * 64 + fr, col0 = u.pn * BM + wc * 32 + 8 * fq;
        float mown[2][4], rr[2][4]; rstd8(rr, pre, C2_X);
#pragma unroll
        for (int ai = 0; ai < 2; ++ai)
#pragma unroll
            for (int m = 0; m < 4; ++m) { const float r = rr[ai][m]; float mx = -INFINITY;
#pragma unroll
                for (int bj = 0; bj < 2; ++bj)
#pragma unroll
                    for (int n = 0; n < 2; ++n) { f32x4 s = acc[ai][bj][m][n] * r; acc[ai][bj][m][n] = s; mx = fmaxf(mx, fmaxf(fmaxf(s[0], s[1]), fmaxf(s[2], s[3]))); }
                mx = quad_max(mx); float l = 0.f;
#pragma unroll
                for (int bj = 0; bj < 2; ++bj)
#pragma unroll
                    for (int n = 0; n < 2; ++n) { f32x4 s = acc[ai][bj][m][n]; f32x4 e;
#pragma unroll
                        for (int j = 0; j < 4; ++j) e[j] = __builtin_amdgcn_exp2f(s[j] - mx);
                        acc[ai][bj][m][n] = e; l += (e[0] + e[1]) + (e[2] + e[3]); }
                l = quad_sum(l);
                mown[ai][m] = mx;
                if (fq == 0) X[(ai * HALF + wr * 64 + m * 16 + fr) * 4 + wc] = (f32x2){mx, l}; }
        asm volatile("s_waitcnt lgkmcnt(0)" ::: "memory"); __builtin_amdgcn_s_barrier(); asm volatile("" ::: "memory");
        TileAddr ta; ta.init(P + xrow(__builtin_amdgcn_readfirstlane(u.pm) * BM, 1024), u.pn, wr, wc, fr, fq);
#pragma unroll
        for (int ai = 0; ai < 2; ++ai)
#pragma unroll
            for (int m = 0; m < 4; ++m) { const int rl = ai * HALF + wr * 64 + m * 16 + fr;
                const f32x2 a = X[rl * 4 + 0], b = X[rl * 4 + 1], c = X[rl * 4 + 2], d = X[rl * 4 + 3];
                const float M = fmaxf(fmaxf(a.x, b.x), fmaxf(c.x, d.x));
                const float L = (a.y * __builtin_amdgcn_exp2f(a.x - M) + b.y * __builtin_amdgcn_exp2f(b.x - M)) + (c.y * __builtin_amdgcn_exp2f(c.x - M) + d.y * __builtin_amdgcn_exp2f(d.x - M));
                const float f = __builtin_amdgcn_exp2f(mown[ai][m] - M) / L;
#pragma unroll
                for (int bj = 0; bj < 2; ++bj) *ta.at(ai, bj, m) = pack8(acc[ai][bj][m][0] * f, acc[ai][bj][m][1] * f); }
    }
};
struct EpiRelu2 {
    bf16_t* F; const rss_t* rowss;
    typedef PreRss Pre; __device__ __forceinline__ void init(Pre&) const {} __device__ __forceinline__ void finish(Pre&, int, int) const {} __device__ __forceinline__ void prefetch(Pre& p, const Unit& u, int wr, int fr) const { rss_prefetch(p, rowss, u.pm * BM + wr * 64 + fr); }
    __device__ __forceinline__ void operator()(f32x4 (&acc)[2][2][4][2], const Unit& u, int wr, int wc, int fr, int fq, const Pre& pre) const {
        const int row0 = u.pm * BM + wr * 64 + fr, col0 = u.pn * BM + wc * 32 + 8 * fq;
        float rr[2][4]; rstd8(rr, pre, 1.0f);
        TileAddr ta; ta.init(F + xrow(__builtin_amdgcn_readfirstlane(u.pm) * BM, FF), u.pn, wr, wc, fr, fq);
#pragma unroll
        for (int ai = 0; ai < 2; ++ai)
#pragma unroll
            for (int m = 0; m < 4; ++m) { const float r = rr[ai][m];
#pragma unroll
                for (int bj = 0; bj < 2; ++bj) { f32x4 v0 = acc[ai][bj][m][0] * r, v1 = acc[ai][bj][m][1] * r;
                    f32x2 q0 = (f32x2){fmaxf(v0[0], 0.f), fmaxf(v0[1], 0.f)}, q1 = (f32x2){fmaxf(v0[2], 0.f), fmaxf(v0[3], 0.f)}, q2 = (f32x2){fmaxf(v1[0], 0.f), fmaxf(v1[1], 0.f)}, q3 = (f32x2){fmaxf(v1[2], 0.f), fmaxf(v1[3], 0.f)};
                    q0 = q0 * q0; q1 = q1 * q1; q2 = q2 * q2; q3 = q3 * q3;
                    u32x4 w; w.x = cvt_pk_bf16(q0[0], q0[1]); w.y = cvt_pk_bf16(q1[0], q1[1]); w.z = cvt_pk_bf16(q2[0], q2[1]); w.w = cvt_pk_bf16(q3[0], q3[1]);
                    *ta.at(ai, bj, m) = w; } }
    }
};
}

namespace attn_body {
using bf16=__hip_bfloat16;
using bf16x8=__attribute__((ext_vector_type(8)))short;
using s16x4=__attribute__((ext_vector_type(4)))short;
using f32x16=__attribute__((ext_vector_type(16)))float;
using u32x4=__attribute__((ext_vector_type(4)))unsigned;
constexpr int SEQL=2048,D=64,PQ=512,PO=1024;
constexpr int NW=8,QBLK=32,QB=QBLK*NW,KVBLK=64,NQB=SEQL/QB;
__device__ __forceinline__ int crow(int r,int hi){return (r&3)+8*(r>>2)+4*hi;}
#define SBAR() __builtin_amdgcn_sched_barrier(0)
__device__ __forceinline__ void cmask(f32x16&p0,f32x16&p1,int jb,int qrel,int hi){
  const float NEG=-INFINITY; int kb=64*jb+4*hi;
  #pragma unroll
  for(int r=0;r<16;++r){int kv=kb+(r&3)+8*(r>>2); if(kv>qrel)p0[r]=NEG; if(kv+32>qrel)p1[r]=NEG;}
}
constexpr int NSLOT=3, SLOTB=8192;
constexpr int LDS_K=0, LDS_V=NSLOT*SLOTB, LDS_WS=2*NSLOT*SLOTB, LDS_OST=LDS_WS+NW*64*4, LDS_BYTES=LDS_OST+NW*4096;
__device__ __forceinline__ void glds16(const void*gsrc,unsigned lds_dst){unsigned keep;
  asm volatile("s_mov_b32 %0, m0\n\ts_mov_b32 m0, %2\n\ts_nop 0\n\tglobal_load_lds_dwordx4 %1, off\n\ts_mov_b32 m0, %0":"=&s"(keep):"v"(gsrc),"s"(lds_dst):"memory");}
__device__ __forceinline__ float max3f(float a,float b,float c){float r;asm("v_max3_f32 %0, %1, %2, %3":"=v"(r):"v"(a),"v"(b),"v"(c));return r;}
__device__ __forceinline__ float max2f(float a,float b){float r;asm("v_max_f32_e32 %0, %1, %2":"=v"(r):"v"(a),"v"(b));return r;}
__device__ __forceinline__ float fadd_s(float a,float b){float r;asm("v_add_f32_e32 %0, %1, %2":"=v"(r):"v"(a),"v"(b));return r;}
__device__ __forceinline__ float fsub_s(float a,float b){float r;asm("v_sub_f32_e32 %0, %1, %2":"=v"(r):"v"(a),"v"(b));return r;}
typedef float f32x2_t __attribute__((ext_vector_type(2))); typedef __bf16 bf16x2_t __attribute__((ext_vector_type(2)));
__device__ __forceinline__ unsigned cvtpk_s(float lo,float hi){f32x2_t v={lo,hi};bf16x2_t b=__builtin_convertvector(v,bf16x2_t);return __builtin_bit_cast(unsigned,b);}
#define WAIT_BAR(N) asm volatile("s_waitcnt vmcnt(" #N ") lgkmcnt(0)\n\ts_barrier":::"memory")

__device__ __forceinline__ void qkt(f32x16&p0,f32x16&p1,const char*Kslot,const bf16x8*qr,const f32x16&negm,int r32,int hi){
  const char*kb=Kslot+hi*1024+r32*16;
  #pragma unroll
  for(int d0=0;d0<4;++d0){
    const bf16x8 b0=*reinterpret_cast<const bf16x8*>(kb+d0*2048);
    const bf16x8 b1=*reinterpret_cast<const bf16x8*>(kb+d0*2048+512);
    if(d0==0){p0=__builtin_amdgcn_mfma_f32_32x32x16_bf16(b0,qr[0],negm,0,0,0);p1=__builtin_amdgcn_mfma_f32_32x32x16_bf16(b1,qr[0],negm,0,0,0);}
    else{p0=__builtin_amdgcn_mfma_f32_32x32x16_bf16(b0,qr[d0],p0,0,0,0);p1=__builtin_amdgcn_mfma_f32_32x32x16_bf16(b1,qr[d0],p1,0,0,0);}}
}
typedef __attribute__((address_space(3))) const char* lds_cptr;
typedef short v4i16_t __attribute__((ext_vector_type(4)));
__device__ __forceinline__ void kload8(bf16x8*kf,lds_cptr kp){
  kf[0]=*(const __attribute__((address_space(3))) bf16x8*)(kp);      kf[1]=*(const __attribute__((address_space(3))) bf16x8*)(kp+512);
  kf[2]=*(const __attribute__((address_space(3))) bf16x8*)(kp+2048); kf[3]=*(const __attribute__((address_space(3))) bf16x8*)(kp+2560);
  kf[4]=*(const __attribute__((address_space(3))) bf16x8*)(kp+4096); kf[5]=*(const __attribute__((address_space(3))) bf16x8*)(kp+4608);
  kf[6]=*(const __attribute__((address_space(3))) bf16x8*)(kp+6144); kf[7]=*(const __attribute__((address_space(3))) bf16x8*)(kp+6656);
}
__device__ __forceinline__ void kload2(bf16x8*kf,lds_cptr kp,int j){ kf[2*j]=*(const __attribute__((address_space(3))) bf16x8*)(kp+j*2048); kf[2*j+1]=*(const __attribute__((address_space(3))) bf16x8*)(kp+j*2048+512); }
__device__ __forceinline__ s16x4 vtr(lds_cptr p){ return __builtin_bit_cast(s16x4,__builtin_amdgcn_ds_read_tr16_b64_v4i16((__attribute__((address_space(3))) v4i16_t*)p)); }
__device__ __forceinline__ float rowmax(const f32x16&p0,const f32x16&p1){
  float a=max3f(p0[0],p0[1],p1[0]),b=max3f(p0[2],p0[3],p1[1]);a=max3f(a,p1[2],p1[3]);
  #pragma unroll
  for(int r=4;r<16;r+=4){a=max3f(a,p0[r],p0[r+1]);b=max3f(b,p0[r+2],p0[r+3]);a=max3f(a,p1[r],p1[r+1]);b=max3f(b,p1[r+2],p1[r+3]);}
  const float m=max2f(a,b);
  auto rr=__builtin_amdgcn_permlane32_swap(__float_as_uint(m),__float_as_uint(m),false,false);
  return max2f(__uint_as_float(rr[0]),__uint_as_float(rr[1]));
}
__device__ __forceinline__ void pv(f32x16*o,int vb,bf16x8 pa0,bf16x8 pa1,bf16x8 pa2,bf16x8 pa3){
  #pragma unroll
  for(int d0=0;d0<2;++d0){s16x4 lo[4],hi[4];
    #pragma unroll
    for(int ks=0;ks<4;++ks){
      asm volatile("ds_read_b64_tr_b16 %0,%1 offset:%c2":"=&v"(lo[ks]):"v"(vb),"i"(d0*4096+ks*1024):"memory");
      asm volatile("ds_read_b64_tr_b16 %0,%1 offset:%c2":"=&v"(hi[ks]):"v"(vb),"i"(d0*4096+ks*1024+512):"memory");}
    asm volatile("s_waitcnt lgkmcnt(0)":::"memory");SBAR();
    #define PK(k) (bf16x8){lo[k][0],lo[k][1],lo[k][2],lo[k][3],hi[k][0],hi[k][1],hi[k][2],hi[k][3]}
    o[d0]=__builtin_amdgcn_mfma_f32_32x32x16_bf16(pa0,PK(0),o[d0],0,0,0);
    o[d0]=__builtin_amdgcn_mfma_f32_32x32x16_bf16(pa1,PK(1),o[d0],0,0,0);
    o[d0]=__builtin_amdgcn_mfma_f32_32x32x16_bf16(pa2,PK(2),o[d0],0,0,0);
    o[d0]=__builtin_amdgcn_mfma_f32_32x32x16_bf16(pa3,PK(3),o[d0],0,0,0);
    #undef PK
  }
}
#define ATTN_STORE16(p,v) (*(u32x4*)(p)=(v))
template<int THRL> __device__ __forceinline__ void attn_unit(int b,int cqk,int cv,int co,int qb,const bf16*Q,const bf16*__restrict__ K,const bf16*__restrict__ V,bf16*O,char*shm,const int tid_in){
  int tid=tid_in; asm volatile("":"+v"(tid));
  const int lane=tid&63,r32=lane&31,hi=lane>>5; const int wid=__builtin_amdgcn_readfirstlane(tid>>6);
  const long rowbase=(long)b*SEQL; const int q0=qb*QB;
  const bf16*Qw=Q+(rowbase+q0+wid*QBLK)*PQ+cqk;
  const bf16*Kh=K+rowbase*PQ+cqk,*Vh=V+rowbase*PQ+cv;
  const unsigned lds0=(unsigned)(uintptr_t)shm;
  float*wsf=(float*)(shm+LDS_WS)+wid*64;
  const bf16*ksrc=Kh+(long)lane*PQ+wid*8;
  const bf16*vsrc=Vh+(long)(16*(wid&3)+(lane>>2))*PQ+(wid>>2)*32+(lane&3)*8;
  const unsigned kdst=lds0+LDS_K+wid*1024, vdst=lds0+LDS_V+wid*1024;
  #define DMA_K(t,slot) glds16(ksrc+(long)(t)*KVBLK*PQ,(unsigned)__builtin_amdgcn_readfirstlane(kdst+(slot)))
  #define DMA_V(t,slot) glds16(vsrc+(long)(t)*KVBLK*PQ,(unsigned)__builtin_amdgcn_readfirstlane(vdst+(slot)))
  const int vb0=(int)(lds0+LDS_V)+((lane>>4)&1)*32+(lane&3)*8+(4*hi+((lane&15)>>2))*64;
  const char*Kbase=shm+LDS_K; bf16x8 kf[8];
  const lds_cptr shm3=(lds_cptr)shm; const lds_cptr kp0=shm3+LDS_K+hi*1024+r32*16; const lds_cptr vp0=shm3+LDS_V+((lane>>4)&1)*32+(lane&3)*8+(4*hi+((lane&15)>>2))*64;
  const int NT=(q0+QB)/KVBLK;
  DMA_K(0,0);DMA_V(0,0);DMA_K(1,SLOTB);
  bf16x8 qr[4];
  #pragma unroll
  for(int d0=0;d0<4;++d0)qr[d0]=*reinterpret_cast<const bf16x8*>(&Qw[(long)r32*PQ+d0*16+hi*8]);
  float zz_=0.f;asm volatile("":"+v"(zz_));float mhat=zz_,l_reg=zz_;f32x16 o[2];f32x16 negm;
  _Pragma("unroll") for(int r=0;r<16;++r){o[0][r]=zz_;o[1][r]=zz_;negm[r]=zz_;} asm volatile("":"+v"(negm));
  const int qrel=wid*QBLK+r32;
  #define CMASK(P0,P1,t) do{int jb_=(t)-(NT-4); if(jb_>=0)cmask(P0,P1,jb_,qrel,hi);}while(0)
  bool resc=false;
  #define START(P0,P1) do{ const float rm=rowmax(P0,P1); resc=false; \
    { const float dl=rm; mhat=fadd_s(mhat,dl); \
      _Pragma("unroll") for(int r=0;r<16;++r){P0[r]=fsub_s(P0[r],dl);P1[r]=fsub_s(P1[r],dl);} \
      _Pragma("unroll") for(int r=0;r<16;++r)negm[r]=-mhat; asm volatile("":"+v"(negm)); } \
    _Pragma("unroll") for(int r=0;r<16;++r)P0[r]=__builtin_amdgcn_exp2f(P0[r]); }while(0)
  #define RESC() do{ if(resc){ asm volatile("s_waitcnt lgkmcnt(0)":::"memory"); \
      _Pragma("unroll") for(int d_=0;d_<2;++d_) _Pragma("unroll") for(int r=0;r<16;++r)o[d_][r]*=wsf[crow(r,hi)]; } }while(0)
  f32x16 pA0,pA1,pB0,pB1;
  int sl_prev=0,sl_cur=0,sl_next=SLOTB;
  #define ROT() do{sl_prev=sl_cur;sl_cur=sl_next;sl_next=(sl_next==(NSLOT-1)*SLOTB)?0:sl_next+SLOTB;}while(0)
  DMA_K(2,2*SLOTB);
  WAIT_BAR(3);
  qkt(pA0,pA1,Kbase,qr,negm,r32,hi);asm volatile("s_nop 15\n\ts_nop 7":"+v"(pA0),"+v"(pA1));CMASK(pA0,pA1,0);
  START(pA0,pA1);
  _Pragma("unroll") for(int r=0;r<16;++r)pA1[r]=__builtin_amdgcn_exp2f(pA1[r]);
  WAIT_BAR(0);
  DMA_K(3,0);DMA_V(1,SLOTB);
  ROT();
  kload8(kf,kp0+sl_cur);
  WAIT_BAR(2);
  s16x4 vlo[8],vhi[8]; u32x4 pw0,pw1,pw2,pw3;
  #define PKW(P,B) cvtpk_s(P[B],P[B+1])
  #define PAF(k) __builtin_bit_cast(bf16x8,pw##k)
  #define VFR(i) (bf16x8){vlo[i][0],vlo[i][1],vlo[i][2],vlo[i][3],vhi[i][0],vhi[i][1],vhi[i][2],vhi[i][3]}
  #define PIN(x) asm volatile("":"+v"(x))
  #define MX3(a,b,c) __builtin_fmaxf(__builtin_fmaxf((a),(b)),(c))
  #define GAPA(MF,A0,A1,A2,A3,W0,W1,PW) do{ MF; sacc+=A0; sacc+=A1; sacc+=A2; sacc+=A3; PIN(sacc); W0; W1; PIN(PW); SBAR(); }while(0)
  #define EX(v) __builtin_amdgcn_exp2f(v)
  #define GAPB(MF,X,B) do{ MF; X[B]=EX(X[B]); X[B+1]=EX(X[B+1]); X[B+2]=EX(X[B+2]); X[B+3]=EX(X[B+3]); PIN(X); SBAR(); }while(0)
  #define VRD(i) do{ vlo[i]=vtr(vp_+(((i)>>2)*4096+((i)&3)*1024)); vhi[i]=vtr(vp_+(((i)>>2)*4096+((i)&3)*1024+512)); }while(0)
  #define KRD(G,j) do{ if(G){ kload2(kf,kp0+sl_next,j); SBAR(); } }while(0)
  #define STEP(C0,C1,P0,P1,t,GK,GV,GL) do{ SBAR(); \
    const lds_cptr vp_=vp0+sl_prev; \
    VRD(0); SBAR(); float sacc=(P0[0]+P0[1]); \
    GAPA(C0=__builtin_amdgcn_mfma_f32_32x32x16_bf16(kf[0],qr[0],negm,0,0,0), P0[2],P0[3],P0[4],P0[5],     pw0[0]=PKW(P0,0), pw0[1]=PKW(P0,2), pw0); \
    VRD(4); SBAR(); GAPA(C1=__builtin_amdgcn_mfma_f32_32x32x16_bf16(kf[1],qr[0],negm,0,0,0), P0[6],P0[7],P0[8],P0[9],     pw0[2]=PKW(P0,4), pw0[3]=PKW(P0,6), pw0); \
    VRD(1); SBAR(); GAPA(C0=__builtin_amdgcn_mfma_f32_32x32x16_bf16(kf[2],qr[1],C0,0,0,0),   P0[10],P0[11],P0[12],P0[13], pw1[0]=PKW(P0,8), pw1[1]=PKW(P0,10), pw1); \
    VRD(5); SBAR(); GAPA(C1=__builtin_amdgcn_mfma_f32_32x32x16_bf16(kf[3],qr[1],C1,0,0,0),   P0[14],P0[15],P1[0],P1[1],   pw1[2]=PKW(P0,12),pw1[3]=PKW(P0,14), pw1); \
    VRD(2); SBAR(); GAPA(C0=__builtin_amdgcn_mfma_f32_32x32x16_bf16(kf[4],qr[2],C0,0,0,0),   P1[2],P1[3],P1[4],P1[5],     pw2[0]=PKW(P1,0), pw2[1]=PKW(P1,2), pw2); \
    VRD(6); SBAR(); GAPA(C1=__builtin_amdgcn_mfma_f32_32x32x16_bf16(kf[5],qr[2],C1,0,0,0),   P1[6],P1[7],P1[8],P1[9],     pw2[2]=PKW(P1,4), pw2[3]=PKW(P1,6), pw2); \
    VRD(3); SBAR(); GAPA(C0=__builtin_amdgcn_mfma_f32_32x32x16_bf16(kf[6],qr[3],C0,0,0,0),   P1[10],P1[11],P1[12],P1[13], pw3[0]=PKW(P1,8), pw3[1]=PKW(P1,10), pw3); \
    VRD(7); SBAR(); GAPA(C1=__builtin_amdgcn_mfma_f32_32x32x16_bf16(kf[7],qr[3],C1,0,0,0),   P1[14],P1[15],0.f,0.f,       pw3[2]=PKW(P1,12),pw3[3]=PKW(P1,14), pw3); \
    l_reg+=sacc; \
    if(GK){DMA_K((t)+3,sl_cur);} if(GV){DMA_V((t)+1,sl_next);} \
    CMASK(C0,C1,t); \
    { float a=MX3(C0[0],C0[1],C1[0]),b=MX3(C0[2],C0[3],C1[1]); a=MX3(a,C1[2],C1[3]); \
      _Pragma("unroll") for(int r=4;r<16;r+=4){a=MX3(a,C0[r],C0[r+1]);b=MX3(b,C0[r+2],C0[r+3]);a=MX3(a,C1[r],C1[r+1]);b=MX3(b,C1[r+2],C1[r+3]);} \
      float rm=__builtin_fmaxf(a,b); { auto rr=__builtin_amdgcn_permlane32_swap(__float_as_uint(rm),__float_as_uint(rm),false,false); rm=__builtin_fmaxf(__uint_as_float(rr[0]),__uint_as_float(rr[1])); } \
      resc=false; \
      if(__builtin_expect(__any(rm>(float)THRL),0)){ const float dl=__builtin_fmaxf(rm,0.f); mhat+=dl; \
        _Pragma("unroll") for(int r=0;r<16;++r){C0[r]-=dl;C1[r]-=dl;} \
        _Pragma("unroll") for(int r=0;r<16;++r)negm[r]=-mhat; asm volatile("":"+v"(negm)); \
        const float f=__builtin_amdgcn_exp2f(-dl); l_reg*=f; if(hi==0)wsf[r32]=f; resc=true; } } \
    SBAR(); \
    GAPB(o[0]=__builtin_amdgcn_mfma_f32_32x32x16_bf16(PAF(0),VFR(0),o[0],0,0,0), C0,0); \
    GAPB(o[1]=__builtin_amdgcn_mfma_f32_32x32x16_bf16(PAF(0),VFR(4),o[1],0,0,0), C0,4); \
    KRD(GL,0); GAPB(o[0]=__builtin_amdgcn_mfma_f32_32x32x16_bf16(PAF(1),VFR(1),o[0],0,0,0), C0,8); \
    KRD(GL,1); GAPB(o[1]=__builtin_amdgcn_mfma_f32_32x32x16_bf16(PAF(1),VFR(5),o[1],0,0,0), C0,12); \
    KRD(GL,2); GAPB(o[0]=__builtin_amdgcn_mfma_f32_32x32x16_bf16(PAF(2),VFR(2),o[0],0,0,0), C1,0); \
    KRD(GL,3); GAPB(o[1]=__builtin_amdgcn_mfma_f32_32x32x16_bf16(PAF(2),VFR(6),o[1],0,0,0), C1,4); \
    GAPB(o[0]=__builtin_amdgcn_mfma_f32_32x32x16_bf16(PAF(3),VFR(3),o[0],0,0,0), C1,8); \
    GAPB(o[1]=__builtin_amdgcn_mfma_f32_32x32x16_bf16(PAF(3),VFR(7),o[1],0,0,0), C1,12); \
    }while(0)
  int t=1;
  #undef CMASK
  #define CMASK(P0,P1,t) do{}while(0)
  for(;t+5<NT;t+=2){
    STEP(pB0,pB1,pA0,pA1,t,true,true,true);     WAIT_BAR(2); RESC(); ROT();
    STEP(pA0,pA1,pB0,pB1,t+1,true,true,true);   WAIT_BAR(2); RESC(); ROT();
  }
  #undef CMASK
  #define CMASK(P0,P1,t) do{int jb_=(t)-(NT-4); if(jb_>=0)cmask(P0,P1,jb_,qrel,hi);}while(0)
  #define ENDW(tt) do{ if((tt)+3<NT){WAIT_BAR(2);} else if((tt)+2<NT){WAIT_BAR(1);} else {WAIT_BAR(0);} }while(0)
  for(;t+1<NT;t+=2){
    STEP(pB0,pB1,pA0,pA1,t,(t+3<NT),(t+1<NT),(t+1<NT));       ENDW(t);   RESC(); ROT();
    STEP(pA0,pA1,pB0,pB1,t+1,(t+4<NT),(t+2<NT),(t+2<NT));     ENDW(t+1); RESC(); ROT();
  }
  STEP(pB0,pB1,pA0,pA1,NT-1,false,false,false); RESC();
  { float sacc=pB0[0]+pB0[1]; _Pragma("unroll") for(int r=2;r<16;++r)sacc+=pB0[r]; _Pragma("unroll") for(int r=0;r<16;++r)sacc+=pB1[r]; l_reg+=sacc;
    pw0=(u32x4){PKW(pB0,0),PKW(pB0,2),PKW(pB0,4),PKW(pB0,6)};pw1=(u32x4){PKW(pB0,8),PKW(pB0,10),PKW(pB0,12),PKW(pB0,14)};pw2=(u32x4){PKW(pB1,0),PKW(pB1,2),PKW(pB1,4),PKW(pB1,6)};pw3=(u32x4){PKW(pB1,8),PKW(pB1,10),PKW(pB1,12),PKW(pB1,14)};
    SBAR(); pv(o,vb0+sl_cur,PAF(0),PAF(1),PAF(2),PAF(3)); }
  #undef PKW
  #undef PAF
  #undef VFR
  #undef PIN
  #undef MX3
  #undef GAPA
  #undef GAPB
  #undef EX
  #undef VRD
  #undef KRD
  #undef STEP
  #undef ENDW
  {auto rr=__builtin_amdgcn_permlane32_swap(__float_as_uint(l_reg),__float_as_uint(l_reg),false,false);l_reg=__uint_as_float(rr[0])+__uint_as_float(rr[1]);}
  if(hi==0)wsf[32+r32]=l_reg;asm volatile("s_waitcnt lgkmcnt(0)":::"memory");
  float rli[16];
  #pragma unroll
  for(int r=0;r<16;++r)rli[r]=__builtin_amdgcn_rcpf(wsf[32+crow(r,hi)]);
  int lane_e=lane; asm volatile("":"+v"(lane_e));
  bf16*Ow=O+(rowbase+q0+wid*QBLK)*PO+co;
  { bf16*stg=(bf16*)(shm+LDS_OST)+wid*2048;
    #pragma unroll
    for(int r=0;r<16;++r){const int orow=crow(r,hi);
      #pragma unroll
      for(int d0=0;d0<2;++d0)stg[orow*64+d0*32+r32]=__float2bfloat16(o[d0][r]*rli[r]);}
    asm volatile("s_waitcnt lgkmcnt(0)":::"memory");
    #pragma unroll
    for(int i=0;i<4;++i){const int row=i*8+(lane_e>>3),ch=lane_e&7; const u32x4 v=*(const u32x4*)(stg+row*64+ch*8); ATTN_STORE16(Ow+(long)row*PO+ch*8,v);} }
  asm volatile("s_waitcnt lgkmcnt(0)\n\ts_barrier":::"memory");
  #undef DMA_K
  #undef DMA_V
  #undef CMASK
  #undef START
  #undef RESC
  #undef ROT
}

constexpr int VSLOTB=2*SLOTB;
constexpr int L2_K=0, L2_V=NSLOT*SLOTB, L2_WS=L2_V+NSLOT*VSLOTB, L2_OST=L2_WS+NW*64*4, LDS128_BYTES=L2_OST+NW*4096;
__device__ __forceinline__ void pv128(f32x16*o,int vb,bf16x8 pa0,bf16x8 pa1,bf16x8 pa2,bf16x8 pa3){
  #pragma unroll
  for(int d0=0;d0<4;++d0){s16x4 lo[4],hi[4];
    #pragma unroll
    for(int ks=0;ks<4;++ks){
      asm volatile("ds_read_b64_tr_b16 %0,%1 offset:%c2":"=&v"(lo[ks]):"v"(vb),"i"(d0*4096+ks*1024):"memory");
      asm volatile("ds_read_b64_tr_b16 %0,%1 offset:%c2":"=&v"(hi[ks]):"v"(vb),"i"(d0*4096+ks*1024+512):"memory");}
    asm volatile("s_waitcnt lgkmcnt(0)":::"memory");SBAR();
    #define PK(k) (bf16x8){lo[k][0],lo[k][1],lo[k][2],lo[k][3],hi[k][0],hi[k][1],hi[k][2],hi[k][3]}
    o[d0]=__builtin_amdgcn_mfma_f32_32x32x16_bf16(pa0,PK(0),o[d0],0,0,0);
    o[d0]=__builtin_amdgcn_mfma_f32_32x32x16_bf16(pa1,PK(1),o[d0],0,0,0);
    o[d0]=__builtin_amdgcn_mfma_f32_32x32x16_bf16(pa2,PK(2),o[d0],0,0,0);
    o[d0]=__builtin_amdgcn_mfma_f32_32x32x16_bf16(pa3,PK(3),o[d0],0,0,0);
    #undef PK
  }
}
template<int THRL> __device__ __forceinline__ void attn_unit128(int b,int cqk,int cv,int co,int qb,const bf16*Q,const bf16*__restrict__ K,const bf16*__restrict__ V,bf16*O,char*shm,const int tid_in){
  int tid=tid_in; asm volatile("":"+v"(tid));
  const int lane=tid&63,r32=lane&31,hi=lane>>5; const int wid=__builtin_amdgcn_readfirstlane(tid>>6);
  const long gsl=(long)(b>>1)*((long)16<<20); const long rowbase=(long)(b&1)*SEQL; const int q0=qb*QB;
  const long pq0=(((rowbase+q0)>>8)<<20), pb0=((rowbase>>8)<<20);
  const bf16*Qw=Q+gsl+pq0+(long)(wid*QBLK)*PQ+cqk;
  const bf16*Kh=K+gsl+pb0+cqk,*Vh=V+gsl+pb0+cv;
  const unsigned lds0=(unsigned)(uintptr_t)shm;
  float*wsf=(float*)(shm+L2_WS)+wid*64;
  const bf16*ksrc=Kh+(long)lane*PQ+wid*8;
  const bf16*vsrc=Vh+(long)(16*(wid&3)+(lane>>2))*PQ+(wid>>2)*32+(lane&3)*8;
  const unsigned kdst=lds0+L2_K+wid*1024, vdst=lds0+L2_V+wid*1024;
  #define TOFF(t) ((((long)(t)>>2)<<20)+((long)(t)&3)*(KVBLK*PQ))
  #define DMA_K(t,slot) glds16(ksrc+TOFF(t),(unsigned)__builtin_amdgcn_readfirstlane(kdst+(slot)))
  #define DMA_V(t,slot) do{ glds16(vsrc+TOFF(t),(unsigned)__builtin_amdgcn_readfirstlane(vdst+2*(slot))); glds16(vsrc+TOFF(t)+64,(unsigned)__builtin_amdgcn_readfirstlane(vdst+2*(slot)+8192)); }while(0)
  const int vb0=(int)(lds0+L2_V)+((lane>>4)&1)*32+(lane&3)*8+(4*hi+((lane&15)>>2))*64;
  const char*Kbase=shm+L2_K; bf16x8 kf[8];
  const lds_cptr shm3=(lds_cptr)shm; const lds_cptr kp0=shm3+L2_K+hi*1024+r32*16; const lds_cptr vp0=shm3+L2_V+((lane>>4)&1)*32+(lane&3)*8+(4*hi+((lane&15)>>2))*64;
  const int NT=(q0+QB)/KVBLK;
  DMA_K(0,0);DMA_V(0,0);DMA_K(1,SLOTB);
  bf16x8 qr[4];
  #pragma unroll
  for(int d0=0;d0<4;++d0)qr[d0]=*reinterpret_cast<const bf16x8*>(&Qw[(long)r32*PQ+d0*16+hi*8]);
  float zz_=0.f;asm volatile("":"+v"(zz_));float mhat=zz_,l_reg=zz_;f32x16 o[4];f32x16 negm;
  _Pragma("unroll") for(int r=0;r<16;++r){o[0][r]=zz_;o[1][r]=zz_;o[2][r]=zz_;o[3][r]=zz_;}
  const f32x16 z16=f32x16{};
  const int qrel=wid*QBLK+r32;
  #define CMASK(P0,P1,t) do{int jb_=(t)-(NT-4); if(jb_>=0)cmask(P0,P1,jb_,qrel,hi);}while(0)
  bool resc=false;
  #define RESC() do{ if(resc){ asm volatile("s_waitcnt lgkmcnt(0)":::"memory"); \
      _Pragma("unroll") for(int d_=0;d_<4;++d_) _Pragma("unroll") for(int r=0;r<16;++r)o[d_][r]*=wsf[crow(r,hi)]; } }while(0)
  f32x16 pA0,pA1,pB0,pB1;
  int sl_prev=0,sl_cur=0,sl_next=SLOTB;
  #define ROT() do{sl_prev=sl_cur;sl_cur=sl_next;sl_next=(sl_next==(NSLOT-1)*SLOTB)?0:sl_next+SLOTB;}while(0)
  DMA_K(2,2*SLOTB);
  asm volatile("s_waitcnt vmcnt(3) lgkmcnt(0)\n\ts_barrier":::"memory");
  { const char*kb=Kbase+hi*1024+r32*16;
    #pragma unroll
    for(int d0=0;d0<4;++d0){ const bf16x8 b0=*reinterpret_cast<const bf16x8*>(kb+d0*2048); const bf16x8 b1=*reinterpret_cast<const bf16x8*>(kb+d0*2048+512);
      if(d0==0){pA0=__builtin_amdgcn_mfma_f32_32x32x16_bf16(b0,qr[0],z16,0,0,0);pA1=__builtin_amdgcn_mfma_f32_32x32x16_bf16(b1,qr[0],z16,0,0,0);}
      else{pA0=__builtin_amdgcn_mfma_f32_32x32x16_bf16(b0,qr[d0],pA0,0,0,0);pA1=__builtin_amdgcn_mfma_f32_32x32x16_bf16(b1,qr[d0],pA1,0,0,0);}} }
  asm volatile("s_nop 15\n\ts_nop 7":"+v"(pA0),"+v"(pA1));CMASK(pA0,pA1,0);
  { const float rm=rowmax(pA0,pA1); mhat=fadd_s(mhat,rm);
    _Pragma("unroll") for(int r=0;r<16;++r)pA0[r]=__builtin_amdgcn_exp2f(fsub_s(pA0[r],mhat));
    _Pragma("unroll") for(int r=0;r<16;++r)pA1[r]=__builtin_amdgcn_exp2f(fsub_s(pA1[r],mhat));
    _Pragma("unroll") for(int r=0;r<16;++r)negm[r]=-mhat; asm volatile("":"+v"(negm)); }
  asm volatile("s_waitcnt vmcnt(0) lgkmcnt(0)\n\ts_barrier":::"memory");
  DMA_K(3,0);DMA_V(1,SLOTB);
  ROT();
  kload8(kf,kp0+sl_cur);
  asm volatile("s_waitcnt vmcnt(3) lgkmcnt(0)\n\ts_barrier":::"memory");
  s16x4 vlo[8],vhi[8]; u32x4 pw0,pw1,pw2,pw3;
  #define PKW(P,B) cvtpk_s(P[B],P[B+1])
  #define PAF(k) __builtin_bit_cast(bf16x8,pw##k)
  #define VFR(i) (bf16x8){vlo[i][0],vlo[i][1],vlo[i][2],vlo[i][3],vhi[i][0],vhi[i][1],vhi[i][2],vhi[i][3]}
  #define PIN(x) asm volatile("":"+v"(x))
  #define MX3(a,b,c) __builtin_fmaxf(__builtin_fmaxf((a),(b)),(c))
  #define GAPA(MF,A0,A1,A2,A3,W0,W1,PW) do{ MF; sacc+=A0; sacc+=A1; sacc+=A2; sacc+=A3; PIN(sacc); W0; W1; PIN(PW); SBAR(); }while(0)
  #define EXM(v) __builtin_amdgcn_exp2f((v))
  #define GAPB(MF,X,B) do{ MF; X[B]=EXM(X[B]); X[B+1]=EXM(X[B+1]); PIN(X); SBAR(); }while(0)
  #define VRD(i) do{ vlo[i]=vtr(vp_+(((i)>>2)*4096+((i)&3)*1024)); vhi[i]=vtr(vp_+(((i)>>2)*4096+((i)&3)*1024+512)); }while(0)
  #define VRD2(i) do{ vlo[i]=vtr(vp_+(8192+((i)>>2)*4096+((i)&3)*1024)); vhi[i]=vtr(vp_+(8192+((i)>>2)*4096+((i)&3)*1024+512)); SBAR(); }while(0)
  #define KRD(G,j) do{ if(G){ kload2(kf,kp0+sl_next,j); SBAR(); } }while(0)
  #define STEP(C0,C1,P0,P1,t,GK,GV,GL) do{ SBAR(); \
    const lds_cptr vp_=vp0+2*sl_prev; \
    VRD(0); SBAR(); float sacc=(P0[0]+P0[1]); \
    GAPA(C0=__builtin_amdgcn_mfma_f32_32x32x16_bf16(kf[0],qr[0],negm,0,0,0), P0[2],P0[3],P0[4],P0[5],     pw0[0]=PKW(P0,0), pw0[1]=PKW(P0,2), pw0); \
    VRD(4); SBAR(); GAPA(C1=__builtin_amdgcn_mfma_f32_32x32x16_bf16(kf[1],qr[0],negm,0,0,0), P0[6],P0[7],P0[8],P0[9],     pw0[2]=PKW(P0,4), pw0[3]=PKW(P0,6), pw0); \
    VRD(1); SBAR(); GAPA(C0=__builtin_amdgcn_mfma_f32_32x32x16_bf16(kf[2],qr[1],C0,0,0,0),   P0[10],P0[11],P0[12],P0[13], pw1[0]=PKW(P0,8), pw1[1]=PKW(P0,10), pw1); \
    VRD(5); SBAR(); GAPA(C1=__builtin_amdgcn_mfma_f32_32x32x16_bf16(kf[3],qr[1],C1,0,0,0),   P0[14],P0[15],P1[0],P1[1],   pw1[2]=PKW(P0,12),pw1[3]=PKW(P0,14), pw1); \
    VRD(2); SBAR(); GAPA(C0=__builtin_amdgcn_mfma_f32_32x32x16_bf16(kf[4],qr[2],C0,0,0,0),   P1[2],P1[3],P1[4],P1[5],     pw2[0]=PKW(P1,0), pw2[1]=PKW(P1,2), pw2); \
    VRD(6); SBAR(); GAPA(C1=__builtin_amdgcn_mfma_f32_32x32x16_bf16(kf[5],qr[2],C1,0,0,0),   P1[6],P1[7],P1[8],P1[9],     pw2[2]=PKW(P1,4), pw2[3]=PKW(P1,6), pw2); \
    VRD(3); SBAR(); GAPA(C0=__builtin_amdgcn_mfma_f32_32x32x16_bf16(kf[6],qr[3],C0,0,0,0),   P1[10],P1[11],P1[12],P1[13], pw3[0]=PKW(P1,8), pw3[1]=PKW(P1,10), pw3); \
    VRD(7); SBAR(); GAPA(C1=__builtin_amdgcn_mfma_f32_32x32x16_bf16(kf[7],qr[3],C1,0,0,0),   P1[14],P1[15],0.f,0.f,       pw3[2]=PKW(P1,12),pw3[3]=PKW(P1,14), pw3); \
    l_reg+=sacc; \
    if(GK){DMA_K((t)+3,sl_cur);} if(GV){DMA_V((t)+1,sl_next);} \
    CMASK(C0,C1,t); \
    { float a=MX3(C0[0],C0[1],C1[0]),b=MX3(C0[2],C0[3],C1[1]); a=MX3(a,C1[2],C1[3]); \
      _Pragma("unroll") for(int r=4;r<16;r+=4){a=MX3(a,C0[r],C0[r+1]);b=MX3(b,C0[r+2],C0[r+3]);a=MX3(a,C1[r],C1[r+1]);b=MX3(b,C1[r+2],C1[r+3]);} \
      float rm=__builtin_fmaxf(a,b); { auto rr=__builtin_amdgcn_permlane32_swap(__float_as_uint(rm),__float_as_uint(rm),false,false); rm=__builtin_fmaxf(__uint_as_float(rr[0]),__uint_as_float(rr[1])); } \
      resc=false; const float gr_=rm; \
      if(__builtin_expect(__any(gr_>(float)THRL),0)){ const float dl=__builtin_fmaxf(gr_,0.f); mhat+=dl; \
        _Pragma("unroll") for(int r=0;r<16;++r){C0[r]-=dl;C1[r]-=dl;} \
        _Pragma("unroll") for(int r=0;r<16;++r)negm[r]=-mhat; asm volatile("":"+v"(negm)); \
        const float f=__builtin_amdgcn_exp2f(-dl); l_reg*=f; if(hi==0)wsf[r32]=f; resc=true; } } \
    SBAR(); \
    GAPB(o[0]=__builtin_amdgcn_mfma_f32_32x32x16_bf16(PAF(0),VFR(0),o[0],0,0,0), C0,0);  VRD2(0); \
    GAPB(o[1]=__builtin_amdgcn_mfma_f32_32x32x16_bf16(PAF(0),VFR(4),o[1],0,0,0), C0,2);  VRD2(4); \
    GAPB(o[0]=__builtin_amdgcn_mfma_f32_32x32x16_bf16(PAF(1),VFR(1),o[0],0,0,0), C0,4);  VRD2(1); \
    GAPB(o[1]=__builtin_amdgcn_mfma_f32_32x32x16_bf16(PAF(1),VFR(5),o[1],0,0,0), C0,6);  VRD2(5); \
    GAPB(o[0]=__builtin_amdgcn_mfma_f32_32x32x16_bf16(PAF(2),VFR(2),o[0],0,0,0), C0,8);  VRD2(2); \
    GAPB(o[1]=__builtin_amdgcn_mfma_f32_32x32x16_bf16(PAF(2),VFR(6),o[1],0,0,0), C0,10); VRD2(6); \
    GAPB(o[0]=__builtin_amdgcn_mfma_f32_32x32x16_bf16(PAF(3),VFR(3),o[0],0,0,0), C0,12); VRD2(3); \
    GAPB(o[1]=__builtin_amdgcn_mfma_f32_32x32x16_bf16(PAF(3),VFR(7),o[1],0,0,0), C0,14); VRD2(7); \
    GAPB(o[2]=__builtin_amdgcn_mfma_f32_32x32x16_bf16(PAF(0),VFR(0),o[2],0,0,0), C1,0); \
    GAPB(o[3]=__builtin_amdgcn_mfma_f32_32x32x16_bf16(PAF(0),VFR(4),o[3],0,0,0), C1,2); \
    KRD(GL,0); GAPB(o[2]=__builtin_amdgcn_mfma_f32_32x32x16_bf16(PAF(1),VFR(1),o[2],0,0,0), C1,4); \
    KRD(GL,1); GAPB(o[3]=__builtin_amdgcn_mfma_f32_32x32x16_bf16(PAF(1),VFR(5),o[3],0,0,0), C1,6); \
    KRD(GL,2); GAPB(o[2]=__builtin_amdgcn_mfma_f32_32x32x16_bf16(PAF(2),VFR(2),o[2],0,0,0), C1,8); \
    KRD(GL,3); GAPB(o[3]=__builtin_amdgcn_mfma_f32_32x32x16_bf16(PAF(2),VFR(6),o[3],0,0,0), C1,10); \
    GAPB(o[2]=__builtin_amdgcn_mfma_f32_32x32x16_bf16(PAF(3),VFR(3),o[2],0,0,0), C1,12); \
    GAPB(o[3]=__builtin_amdgcn_mfma_f32_32x32x16_bf16(PAF(3),VFR(7),o[3],0,0,0), C1,14); \
    }while(0)
  #define WB3() asm volatile("s_waitcnt vmcnt(3) lgkmcnt(0)\n\ts_barrier":::"memory")
  #define WB2() asm volatile("s_waitcnt vmcnt(2) lgkmcnt(0)\n\ts_barrier":::"memory")
  #define WB0() asm volatile("s_waitcnt vmcnt(0) lgkmcnt(0)\n\ts_barrier":::"memory")
  int t=1;
  #undef CMASK
  #define CMASK(P0,P1,t) do{}while(0)
  for(;t+5<NT;t+=2){
    STEP(pB0,pB1,pA0,pA1,t,true,true,true);     WB3(); RESC(); ROT();
    STEP(pA0,pA1,pB0,pB1,t+1,true,true,true);   WB3(); RESC(); ROT();
  }
  #undef CMASK
  #define CMASK(P0,P1,t) do{int jb_=(t)-(NT-4); if(jb_>=0)cmask(P0,P1,jb_,qrel,hi);}while(0)
  #define ENDW(tt) do{ if((tt)+3<NT){WB3();} else if((tt)+2<NT){WB2();} else {WB0();} }while(0)
  for(;t+1<NT;t+=2){
    STEP(pB0,pB1,pA0,pA1,t,(t+3<NT),(t+1<NT),(t+1<NT));       ENDW(t);   RESC(); ROT();
    STEP(pA0,pA1,pB0,pB1,t+1,(t+4<NT),(t+2<NT),(t+2<NT));     ENDW(t+1); RESC(); ROT();
  }
  STEP(pB0,pB1,pA0,pA1,NT-1,false,false,false); RESC();
  { float sacc=pB0[0]+pB0[1]; _Pragma("unroll") for(int r=2;r<16;++r)sacc+=pB0[r]; _Pragma("unroll") for(int r=0;r<16;++r)sacc+=pB1[r]; l_reg+=sacc;
    pw0=(u32x4){PKW(pB0,0),PKW(pB0,2),PKW(pB0,4),PKW(pB0,6)};pw1=(u32x4){PKW(pB0,8),PKW(pB0,10),PKW(pB0,12),PKW(pB0,14)};pw2=(u32x4){PKW(pB1,0),PKW(pB1,2),PKW(pB1,4),PKW(pB1,6)};pw3=(u32x4){PKW(pB1,8),PKW(pB1,10),PKW(pB1,12),PKW(pB1,14)};
    SBAR(); pv128(o,vb0+2*sl_cur,PAF(0),PAF(1),PAF(2),PAF(3)); }
  #undef PKW
  #undef PAF
  #undef VFR
  #undef PIN
  #undef MX3
  #undef GAPA
  #undef GAPB
  #undef EXM
  #undef VRD
  #undef VRD2
  #undef KRD
  #undef STEP
  #undef ENDW
  #undef WB3
  #undef WB2
  #undef WB0
  {auto rr=__builtin_amdgcn_permlane32_swap(__float_as_uint(l_reg),__float_as_uint(l_reg),false,false);l_reg=__uint_as_float(rr[0])+__uint_as_float(rr[1]);}
  if(hi==0)wsf[32+r32]=l_reg;asm volatile("s_waitcnt lgkmcnt(0)":::"memory");
  float rli[16];
  #pragma unroll
  for(int r=0;r<16;++r)rli[r]=__builtin_amdgcn_rcpf(wsf[32+crow(r,hi)]);
  int lane_e=lane; asm volatile("":"+v"(lane_e));
  bf16*Ow=O+gsl+pq0+(long)(wid*QBLK)*PO+co;
  { bf16*stg=(bf16*)(shm+L2_OST)+wid*2048;
    #pragma unroll
    for(int hf=0;hf<2;++hf){
      #pragma unroll
      for(int r=0;r<16;++r){const int orow=crow(r,hi);
        #pragma unroll
        for(int d0=0;d0<2;++d0)stg[orow*64+d0*32+r32]=__float2bfloat16(o[2*hf+d0][r]*rli[r]);}
      asm volatile("s_waitcnt lgkmcnt(0)":::"memory");
      #pragma unroll
      for(int i=0;i<4;++i){const int row=i*8+(lane_e>>3),ch=lane_e&7; const u32x4 v=*(const u32x4*)(stg+row*64+ch*8); ATTN_STORE16(Ow+(long)row*PO+hf*64+ch*8,v);}
      asm volatile("s_waitcnt lgkmcnt(0)":::"memory"); } }
  asm volatile("s_waitcnt lgkmcnt(0)\n\ts_barrier":::"memory");
  #undef DMA_K
  #undef TOFF
  #undef DMA_V
  #undef CMASK
  #undef RESC
  #undef ROT
}
constexpr int ATTN_LDS_BYTES=LDS_BYTES;
#undef SBAR
#undef WAIT_BAR
}

constexpr int NWAVES = 8;
constexpr size_t MiB = 1u << 20;
constexpr size_t WS_CTL = 0, CTL_ZERO_BYTES = 3 * MiB;
constexpr size_t WS_ROWSS = 1 * MiB;
constexpr size_t WS_CS = 492 * MiB;
constexpr size_t WS_W = 4 * MiB, W_LAYER = 32 * MiB;
constexpr size_t WO_IN = 0, WO_MIX = 6 * MiB, WO_QG = 8 * MiB, WO_O = 10 * MiB, WO_KV = 12 * MiB, WO_1 = 16 * MiB, WO_2 = 24 * MiB;
constexpr size_t WS_MEMN = 68 * MiB;
constexpr size_t WS_KV = 76 * MiB, KV_LAYER = 16 * MiB;
constexpr size_t WS_WQK = 108 * MiB, WS_VWO = 140 * MiB;
constexpr size_t WS_HB = 172 * MiB;
constexpr size_t WS_X = 236 * MiB;
constexpr size_t KiB = 1024;
constexpr size_t X_Q = 0, X_K = 256 * KiB, X_V = 512 * KiB, X_BG = 768 * KiB, X_U = 1024 * KiB, X_O = 1280 * KiB, X_MIX = 0, X_P = 512 * KiB, X_F = 0;
constexpr size_t WS_HALO = 494 * MiB;
constexpr size_t WS_END = 495 * MiB;
constexpr int CW_BAR = 4096;

constexpr int RING_OFF = 0, RING_BYTES = 131072;
constexpr int LDSCTL_OFF = RING_BYTES, MISC_OFF = LDSCTL_OFF + 320, EPIX_OFF = RING_BYTES + 1024;
constexpr int LDS_BYTES = 147456;
static_assert(EPIX_OFF + 8192 <= LDS_BYTES && MISC_OFF + 128 <= EPIX_OFF, "LDS map");

#define GAS __attribute__((address_space(1)))
#define LAS __attribute__((address_space(3)))
typedef unsigned short bf16;
typedef unsigned v4u __attribute__((ext_vector_type(4)));
typedef unsigned v2u __attribute__((ext_vector_type(2)));
typedef float f32x4 __attribute__((ext_vector_type(4)));
typedef GAS unsigned gu32;
#define RLX_AGENT __ATOMIC_RELAXED, __HIP_MEMORY_SCOPE_AGENT
#define LDS_WAIT() asm volatile("s_waitcnt lgkmcnt(0)" ::: "memory")
#define VM_WAIT() asm volatile("s_waitcnt vmcnt(0)" ::: "memory")
__device__ __forceinline__ unsigned f2bf(float f) { unsigned u = __builtin_bit_cast(unsigned, f); return (u + 0x7fffu + ((u >> 16) & 1u)) >> 16; }
__device__ __forceinline__ unsigned pk2(float lo, float hi) { return f2bf(lo) | (f2bf(hi) << 16); }
__device__ __forceinline__ float bflo(unsigned w) { return __uint_as_float(w << 16); }
__device__ __forceinline__ float bfhi(unsigned w) { return __uint_as_float(w & 0xffff0000u); }

#define XB_TMO      128
#define XB_XCNT(j)  (256  + 64 * (j))
#define XB_XSUB(j)  (1280 + 64 * (j))
#define XB_XGEN(j)  (2304 + 64 * (j))
#define XB_TOP      3328
#define XB_TOPGEN   3392
#define XCD_BAR_WORDS 3456
#define XB_LSUB(j)  (3520 + 64 * (j))
#define XB_XID(w)   (4608 + (w))
#define XB_PAIR(i)  (8192 + 16 * (i))
#define XB_A_SUB(x) (10240 + 16 * (x))
#define XB_A_TOP    10496
#define XB_A_DONE   10512
#define XB_BAD      4928
#define XB_SPIN_CAP (1u << 18)
__device__ __forceinline__ unsigned xb_ld(unsigned* p)              { return __hip_atomic_load(p, __ATOMIC_RELAXED, __HIP_MEMORY_SCOPE_AGENT); }
__device__ __forceinline__ unsigned xb_add(unsigned* p, unsigned v) { return __hip_atomic_fetch_add(p, v, __ATOMIC_RELAXED, __HIP_MEMORY_SCOPE_AGENT); }
__device__ __forceinline__ unsigned xb_xcc_id() { return (unsigned)__builtin_amdgcn_s_getreg((3 << 11) | 20) & 0xFu; }
#define XB_SPIN(cond, bar) do { unsigned _sp = 0; while (cond) { __builtin_amdgcn_s_sleep(1); \
    if ((++_sp & 255u) == 0u) { if (xb_ld(&(bar)[XB_TMO])) break; if (_sp > XB_SPIN_CAP) { atomicAdd(&(bar)[XB_TMO], 1u); break; } } } } while (0)
struct XcdBarrier { unsigned* bar; unsigned x; volatile LAS unsigned* st; };
__device__ __forceinline__ XcdBarrier xcd_barrier_post(unsigned* bar, volatile LAS unsigned* st) {
    XcdBarrier b; b.bar = bar; b.x = xb_xcc_id(); b.st = st;
    if (threadIdx.x == 0) (void)xb_add(&bar[XB_XCNT(b.x)], 1u);
    return b;
}
__device__ __forceinline__ void xcd_barrier_complete(unsigned* bar, unsigned x, unsigned& nloc, unsigned& nx) {
    const unsigned G = gridDim.x * gridDim.y * gridDim.z;
    unsigned sum, cnt, mine, sp = 0u;
    for (;;) {
        sum = 0u; cnt = 0u; mine = 0u;
#pragma unroll
        for (unsigned j = 0; j < 16; ++j) { const unsigned c = xb_ld(&bar[XB_XCNT(j)]); sum += c; cnt += (c > 0u) ? 1u : 0u; }
        mine = xb_ld(&bar[XB_XCNT(x)]);
        if (sum == G) break;
        __builtin_amdgcn_s_sleep(1);
        if ((++sp & 255u) == 0u) { if (xb_ld(&bar[XB_TMO])) break; if (sp > XB_SPIN_CAP) { atomicAdd(&bar[XB_TMO], 1u); break; } }
    }
    nloc = mine > 0u ? mine : 1u; nx = cnt > 0u ? cnt : 1u;
}
__device__ __forceinline__ void xcd_barrier(const XcdBarrier& b, const bool leader) {
    asm volatile("s_waitcnt vmcnt(0)" ::: "memory");
    __syncthreads();
    if (leader) {
        unsigned* bar = b.bar;
        __builtin_amdgcn_s_waitcnt(0);
        unsigned nloc = b.st[0], nx = b.st[1];
        if (nloc == 0u) { xcd_barrier_complete(bar, b.x, nloc, nx); b.st[0] = nloc; b.st[1] = nx; }
        const unsigned old = xb_add(&bar[XB_XSUB(b.x)], 1u);
        const unsigned gen = old / nloc;
        if (old + 1u == (gen + 1u) * nloc) {
            __builtin_amdgcn_fence(__ATOMIC_RELEASE, "agent");
            asm volatile("s_waitcnt vmcnt(0)" ::: "memory");
            const unsigned og = xb_add(&bar[XB_TOP], 1u);
            const unsigned tg = og / nx;
            if (og + 1u == (tg + 1u) * nx) xb_add(&bar[XB_TOPGEN], 1u);
            else XB_SPIN(xb_ld(&bar[XB_TOPGEN]) == tg, bar);
            __builtin_amdgcn_fence(__ATOMIC_ACQUIRE, "agent");
            xb_add(&bar[XB_XGEN(b.x)], 1u);
            asm volatile("s_waitcnt vmcnt(0)" ::: "memory");
        } else {
            XB_SPIN(xb_ld(&bar[XB_XGEN(b.x)]) == gen, bar);
            __builtin_amdgcn_fence(__ATOMIC_ACQUIRE, "agent");
            asm volatile("s_waitcnt vmcnt(0)" ::: "memory");
        }
    }
    __syncthreads();
}

__device__ __forceinline__ void xcd_arrive_once(const XcdBarrier& b, const bool leader) {
    asm volatile("s_waitcnt vmcnt(0)" ::: "memory");
    __syncthreads();
    if (leader) {
        unsigned* bar = b.bar;
        __builtin_amdgcn_s_waitcnt(0);
        unsigned nloc = b.st[0], nx = b.st[1];
        if (nloc == 0u) { xcd_barrier_complete(bar, b.x, nloc, nx); b.st[0] = nloc; b.st[1] = nx; }
        const unsigned old = xb_add(&bar[XB_A_SUB(b.x)], 1u);
        if (old + 1u == nloc) {
            __builtin_amdgcn_fence(__ATOMIC_RELEASE, "agent");
            asm volatile("s_waitcnt vmcnt(0)" ::: "memory");
            const unsigned og = xb_add(&bar[XB_A_TOP], 1u);
            if (og + 1u == nx) (void)xb_add(&bar[XB_A_DONE], 1u);
        }
    }
    __syncthreads();
}
__device__ __forceinline__ void xcd_wait_once(const XcdBarrier& b, const bool leader) {
    if (leader) { XB_SPIN(xb_ld(&b.bar[XB_A_DONE]) == 0u, b.bar); __builtin_amdgcn_fence(__ATOMIC_ACQUIRE, "agent"); asm volatile("s_waitcnt vmcnt(0)" ::: "memory"); }
    __syncthreads();
}

__device__ __forceinline__ void pair_barrier(const XcdBarrier& b, const bool leader, const int pi) {
    asm volatile("s_waitcnt vmcnt(0)" ::: "memory");
    __syncthreads();
    if (leader) {
        unsigned* bar = b.bar;
        __builtin_amdgcn_s_waitcnt(0);
        const unsigned k = b.st[3] + 1u; b.st[3] = k;
        const unsigned target = 4u * k;
        (void)__hip_atomic_fetch_add(&bar[XB_PAIR(pi)], 1u, __ATOMIC_RELAXED, __HIP_MEMORY_SCOPE_AGENT);
        XB_SPIN(xb_ld(&bar[XB_PAIR(pi)]) < target, bar);
        __builtin_amdgcn_fence(__ATOMIC_ACQUIRE, "agent");
        asm volatile("s_waitcnt vmcnt(0)" ::: "memory");
    }
    __syncthreads();
}

__device__ __forceinline__ void xcc_barrier(const XcdBarrier& b, const bool leader) {
    asm volatile("s_waitcnt vmcnt(0)" ::: "memory");
    __syncthreads();
    if (leader) {
        unsigned* bar = b.bar;
        __builtin_amdgcn_s_waitcnt(0);
        const unsigned nloc = b.st[0];
        const unsigned k = b.st[2] + 1u; b.st[2] = k;
        const unsigned target = k * nloc;
        (void)__hip_atomic_fetch_add(&bar[XB_LSUB(b.x)], 1u, __ATOMIC_RELAXED, __HIP_MEMORY_SCOPE_AGENT);
        XB_SPIN(xb_ld(&bar[XB_LSUB(b.x)]) < target, bar);
        __builtin_amdgcn_fence(__ATOMIC_ACQUIRE, "agent");
        asm volatile("s_waitcnt vmcnt(0)" ::: "memory");
    }
    __syncthreads();
}

struct Frame {
    LAS unsigned char* lds;
    int tid, lane, wave, vcu, G, bx;
};
__device__ __forceinline__ float shx(float x, int mask) { unsigned on_ = ~0u; asm volatile("" : "+s"(on_)); const int l = (int)__builtin_amdgcn_mbcnt_hi(on_, __builtin_amdgcn_mbcnt_lo(on_, 0u));
    return __builtin_bit_cast(float, __builtin_amdgcn_ds_bpermute((l ^ mask) << 2, __builtin_bit_cast(int, x))); }
__device__ __forceinline__ float wave_sum(float v) {
#pragma unroll
    for (int o = 1; o < 64; o <<= 1) v += shx(v, o);
    return v;
}

__device__ __forceinline__ void p0_transpose_item(const float* W, int K, int N, bf16* WT, int dst_row0, const float* g, LAS float* scr, int kb, int nb, int lane, const bool tiled) {
    const int k0 = 64 * kb, n0 = 32 * nb;
    float wv[32];
#pragma unroll
    for (int i = 0; i < 32; ++i) { const int kk = 2 * i + (lane >> 5); wv[i] = W[(size_t)(k0 + kk) * N + n0 + (lane & 31)]; }
#pragma unroll
    for (int i = 0; i < 32; ++i) { const int kk = 2 * i + (lane >> 5); float w = wv[i]; if (g) w *= g[k0 + kk]; scr[kk * 33 + (lane & 31)] = w; }
    LDS_WAIT(); asm volatile("" ::: "memory");
    const int c = lane & 7;
#pragma unroll
    for (int j = 0; j < 4; ++j) { const int n = (lane >> 3) + 8 * j; const LAS float* s = scr + (8 * c) * 33 + n;
        v4u o; o.x = pk2(s[0 * 33], s[1 * 33]); o.y = pk2(s[2 * 33], s[3 * 33]); o.z = pk2(s[4 * 33], s[5 * 33]); o.w = pk2(s[6 * 33], s[7 * 33]);
        const size_t off = tiled ? pg8::btile_off(dst_row0 + n, k0 + 8 * c, K) : (size_t)(dst_row0 + n) * K + k0 + 8 * c;
        *(GAS v4u*)(WT + off) = o; }
    LDS_WAIT(); asm volatile("" ::: "memory");
}
__device__ __forceinline__ int win_dst_row(int n) {
    if (n < 2048) return n;
    if (n < 2560) { const int ch = n - 2048; return 2048 + 256 * (ch >> 7) + (ch & 127); }
    const int ch = n - 2560; return 2048 + 256 * (ch >> 7) + 128 + (ch & 127);
}
__device__ __forceinline__ void sincos_d(double x, float& s, float& c) {
    const double k = __builtin_rint(x * 0.63661977236758134308);
    double r = __builtin_fma(-k, 1.57079632679489655800e+00, x); r = __builtin_fma(-k, 6.12323399573676603587e-17, r);
    const double r2 = r * r;
    double sp = -7.6471637318198164759e-13; sp = sp * r2 + 1.6059043836821614599e-10; sp = sp * r2 - 2.5052108385441718775e-08; sp = sp * r2 + 2.7557319223985890653e-06;
    sp = sp * r2 - 1.9841269841269841270e-04; sp = sp * r2 + 8.3333333333333333333e-03; sp = sp * r2 - 1.6666666666666666667e-01; const double sn = r + r * r2 * sp;
    double cp = 4.7794773323873852974e-14; cp = cp * r2 - 1.1470745597729724714e-11; cp = cp * r2 + 2.0876756987868098979e-09; cp = cp * r2 - 2.7557319223985890653e-07;
    cp = cp * r2 + 2.4801587301587301587e-05; cp = cp * r2 - 1.3888888888888888889e-03; cp = cp * r2 + 4.1666666666666666667e-02; const double cn = 1.0 - 0.5 * r2 + r2 * r2 * cp;
    const int q = ((int)(long long)k) & 3;
    const double ss = (q == 0) ? sn : (q == 1) ? cn : (q == 2) ? -sn : -cn;
    const double cc = (q == 0) ? cn : (q == 1) ? -sn : (q == 2) ? -cn : sn;
    s = (float)ss; c = (float)cc;
}

struct Args { const void* in[21]; float* out; unsigned char* ws; int ph_lo, ph_hi, li, pad; };
constexpr int NPH = 18;

#ifndef PROBE_REP
#define PROBE_REP -1
#endif
#define NREP(k) ((PROBE_REP == (k)) ? 2 : 1)
#ifndef PH_MASK
#define PH_MASK 0xfff
#endif
#define PHON(k) (((PH_MASK) >> (k)) & 1)
#define INP(i) ((const float*)args.in[i])
#define WSP(T, off) ((T*)((GAS T*)(wsb + (off))))
__global__ void __launch_bounds__(NWAVES * 64, 2) fwd_kernel(Args args) {
    extern __shared__ __attribute__((aligned(16))) unsigned char lds[];
    Frame F;
    F.lds = (LAS unsigned char*)lds;
    volatile LAS unsigned* MISC = (volatile LAS unsigned*)(F.lds + MISC_OFF);
    F.tid = threadIdx.x; F.lane = F.tid & 63; F.wave = __builtin_amdgcn_readfirstlane(F.tid >> 6);
    const int wave0 = F.wave;
    F.G = gridDim.x; { const int bx = blockIdx.x; F.bx = bx; F.vcu = (F.G % 8 == 0) ? (bx % 8) * (F.G / 8) + bx / 8 : bx; }
    for (int u = F.tid; u < (LDS_BYTES - LDSCTL_OFF) / 4; u += NWAVES * 64) ((LAS unsigned*)(F.lds + LDSCTL_OFF))[u] = 0u;
    __syncthreads();
    XcdBarrier bar; bar.bar = (unsigned*)(args.ws + WS_CTL) + CW_BAR; bar.x = 0; bar.st = nullptr;
    if (!MK_PER_PHASE) { bar = xcd_barrier_post((unsigned*)(args.ws + WS_CTL) + CW_BAR, MISC + 8);
        if (threadIdx.x == 0) __hip_atomic_store(bar.bar + XB_XID(blockIdx.x), bar.x + 1u, RLX_AGENT); }
    bool local_ok = false;

    if (args.ph_lo == 0) {
        GAS unsigned char* wsb = (GAS unsigned char*)args.ws;
        const int gw = F.vcu * NWAVES + F.wave, NGW = F.G * NWAVES;
        for (int rp = 0; rp < NREP(0); ++rp) { if (PHON(0)) {
            LAS float* scr = (LAS float*)(F.lds + RING_OFF + F.wave * 16384);
            constexpr int I_IN = 16 * 96, I_MIX = 16 * 32, I_O = 16 * 32, I_KV = 16 * 64, I_1 = 16 * 128, I_2 = 64 * 32, I_L = I_IN + I_MIX + I_O + I_KV + I_1 + I_2;
            for (int it = gw; it < DEPTH * I_L; it += NGW) {
                const int l = it / I_L; int r = it % I_L; unsigned char* wl = (unsigned char*)(wsb + WS_W + (size_t)l * W_LAYER);
                if (r < I_IN) { const int kb = r / 96, nb = r % 96; p0_transpose_item(INP(4) + (size_t)l * DM * INC, DM, INC, (bf16*)(wl + WO_IN), win_dst_row(32 * nb), INP(3) + l * DM, scr, kb, nb, F.lane, true); continue; } r -= I_IN;
                if (r < I_MIX) { const int kb = r / 32, nb = r % 32; p0_transpose_item(INP(11) + (size_t)l * DM * DM, DM, DM, (bf16*)(wl + WO_MIX), 32 * nb, nullptr, scr, kb, nb, F.lane, true); continue; } r -= I_MIX;
                if (r < I_O) { const int kb = r / 32, nb = r % 32; p0_transpose_item(INP(16) + (size_t)l * DM * DM, DM, DM, (bf16*)(wl + WO_O), 32 * nb, nullptr, scr, kb, nb, F.lane, false); continue; } r -= I_O;
                if (r < I_KV) { const int kb = r / 64, nb = r % 64; p0_transpose_item(INP(15) + (size_t)l * DM * 2 * DM, DM, 2 * DM, (bf16*)(wl + WO_KV), 32 * nb, nullptr, scr, kb, nb, F.lane, true); continue; } r -= I_KV;
                if (r < I_1) { const int kb = r / 128, nb = r % 128; p0_transpose_item(INP(18) + (size_t)l * DM * FF, DM, FF, (bf16*)(wl + WO_1), 32 * nb, INP(17) + l * DM, scr, kb, nb, F.lane, true); continue; } r -= I_1;
                { const int kb = r / 32, nb = r % 32; p0_transpose_item(INP(19) + (size_t)l * FF * DM, FF, DM, (bf16*)(wl + WO_2), 32 * nb, nullptr, scr, kb, nb, F.lane, true); }
            }
            { const int gt = F.vcu * (NWAVES * 64) + F.tid, NGT = F.G * NWAVES * 64;
              const float* w_xq = INP(14); const float* norm_x_g = INP(12);
              for (int it = gt; it < DEPTH * DM * DM / 8; it += NGT) { const int l = it / (DM * DM / 8), e = (it % (DM * DM / 8)) * 8, k = e / DM;
                  const f32x4 a = *(const f32x4*)(w_xq + (size_t)l * DM * DM + e), b = *(const f32x4*)(w_xq + (size_t)l * DM * DM + e + 4); const float g = norm_x_g[l * DM + k];
                  v4u o; o.x = pk2(a[0] * g, a[1] * g); o.y = pk2(a[2] * g, a[3] * g); o.z = pk2(b[0] * g, b[1] * g); o.w = pk2(b[2] * g, b[3] * g);
                  *((GAS v4u*)(wsb + WS_W + (size_t)l * W_LAYER + WO_QG + (size_t)e * 2)) = o; }
              const int* positions = (const int*)args.in[2]; float* cstab = WSP(float, WS_CS);
              for (int it = gt; it < MTOK * 8; it += NGT) { const int row = it >> 3, i = it & 7;
                  double f = 1.0;
                  f = (i == 1) ? 0.19392274474868576 : f; f = (i == 2) ? 0.03760603093086393 : f; f = (i == 3) ? 0.007292664737217109 : f; f = (i == 4) ? 0.001414213562373095 : f;
                  f = (i == 5) ? 0.0002742481756762073 : f; f = (i == 6) ? 5.318295896944988e-05 : f; f = (i == 7) ? 1.031338537721246e-05 : f;
                  float s, c; sincos_d((double)positions[row] * f, s, c); cstab[(size_t)row * 16 + i] = c; cstab[(size_t)row * 16 + 8 + i] = s; }
            }
            { const float* mem = INP(1); const float* mem_norm_g = INP(13); bf16* MEMN = WSP(bf16, WS_MEMN);
            for (int m = gw; m < MMEM; m += NGW) {
                const GAS f32x4* xr = (const GAS f32x4*)(mem + (size_t)m * DM) + F.lane; f32x4 v[4]; float s = 0.f;
#pragma unroll
                for (int j = 0; j < 4; ++j) { v[j] = xr[64 * j]; s += (v[j].x * v[j].x + v[j].y * v[j].y) + (v[j].z * v[j].z + v[j].w * v[j].w); }
                const float r = 1.0f / sqrtf(wave_sum(s) * (1.0f / DM) + NORM_EPS);
                GAS v2u* o8 = (GAS v2u*)(MEMN + (size_t)m * DM) + F.lane;
#pragma unroll
                for (int j = 0; j < 4; ++j) { const f32x4 g = *((const f32x4*)mem_norm_g + F.lane + 64 * j); v2u w; w.x = pk2(v[j].x * r * g.x, v[j].y * r * g.y); w.y = pk2(v[j].z * r * g.z, v[j].w * r * g.w); o8[64 * j] = w; }
            } }
            if (!MK_PER_PHASE && 1 < args.ph_hi) xcd_arrive_once(bar, F.tid == 0);
            { const float* x = INP(0); pg8::rss_t* rowss = WSP(pg8::rss_t, WS_ROWSS); bf16* HB = WSP(bf16, WS_HB); float* out = args.out;
            for (int rb = gw; rb < MTOK / 16; rb += NGW) {
                const int m = rb * 16 + (F.lane >> 2), c4 = F.lane & 3; const float* xr = x + (size_t)m * DM + c4 * 8; bf16* pan = HB + (size_t)(m >> 8) * 256 * DM; float s = 0.f;
#pragma unroll 8
                for (int g = 0; g < 32; ++g) { const f32x4 a = *(const GAS f32x4*)(xr + g * 32), b2 = *(const GAS f32x4*)(xr + g * 32 + 4);
                    s += (a.x * a.x + a.y * a.y) + (a.z * a.z + a.w * a.w) + (b2.x * b2.x + b2.y * b2.y) + (b2.z * b2.z + b2.w * b2.w);
                    v4u o; o.x = pk2(a.x, a.y); o.y = pk2(a.z, a.w); o.z = pk2(b2.x, b2.y); o.w = pk2(b2.z, b2.w);
                    *(GAS v4u*)(pan + pg8::atile_off(m & 255, g * 32 + c4 * 8)) = o; }
                s += shx(s, 1); s += shx(s, 2);
                if (c4 == 0) rowss[m] = pg8::rss_fix(s);
            } }
        } }
        if (!MK_PER_PHASE && 1 < args.ph_hi) {
            xcd_wait_once(bar, F.tid == 0);
            if (F.tid < 64) { const int ln0 = F.tid; const unsigned ref = __hip_atomic_load(bar.bar + XB_XID(ln0 & 7), RLX_AGENT); bool bad = (ref == 0u) || (gridDim.x != 256);
#pragma unroll
                for (int k4 = 0; k4 < 4; ++k4) bad = bad || (__hip_atomic_load(bar.bar + XB_XID(ln0 + 64 * k4), RLX_AGENT) != ref);
                const bool anyb = __any(bad); if (ln0 == 0) bar.st[5] = anyb ? 0u : 1u; }
            __syncthreads();
            local_ok = (bar.st[5] != 0u);
            if (local_ok) pair_barrier(bar, F.tid == 0, ((int)(blockIdx.x % 8) * 32 + (int)(blockIdx.x / 8)) >> 2); else xcd_barrier(bar, F.tid == 0);
        }
    }
    for (int ph0 = (args.ph_lo > 1 ? args.ph_lo : 1); ph0 < args.ph_hi; ++ph0) {
      const int ptype = (ph0 == NPH - 1) ? 9 : 1 + (ph0 - 1) % 8; const int nrep = (ptype == PROBE_REP) ? 2 : 1;
      for (int rp = 0; rp < nrep; ++rp) {
        int ph = ph0; asm volatile("" : "+s"(ph));
#define PHASE_TID() do { unsigned ones_ = ~0u; asm volatile("" : "+s"(ones_)); int t_ = (wave0 << 6) | (int)__builtin_amdgcn_mbcnt_hi(ones_, __builtin_amdgcn_mbcnt_lo(ones_, 0u)); asm volatile("" : "+v"(t_)); F.tid = t_; F.lane = t_ & 63; } while (0)
        { F.wave = wave0; int bx_ = blockIdx.x, g_ = gridDim.x; asm volatile("" : "+s"(bx_), "+s"(g_)); F.G = g_; F.bx = bx_; F.vcu = (g_ % 8 == 0) ? (bx_ % 8) * (g_ / 8) + bx_ / 8 : bx_; }
        GAS unsigned char* wsb = (GAS unsigned char*)args.ws; asm volatile("" : "+s"(wsb));
        const int gw = F.vcu * NWAVES + F.wave, NGW = F.G * NWAVES;
        if (ph == NPH - 1) { { PHASE_TID();
            const pg8::rss_t* rs_fin = WSP(pg8::rss_t, WS_ROWSS) + (size_t)6 * MTOK; const float* final_g = INP(20); float* out = args.out;
            const bool dead = (!MK_PER_PHASE) && (xb_ld(WSP(unsigned, WS_CTL) + CW_BAR + XB_TMO) != 0u);
            { const int m = gw * 16 + (F.lane >> 2), c4 = F.lane & 3;
                const float r = pg8::rstd_of(rs_fin, m); const bf16* pan = WSP(bf16, WS_HB) + (size_t)(m >> 8) * 256 * DM; float* orow = out + (size_t)m * DM + c4 * 8;
#pragma unroll 8
                for (int g = 0; g < 32; ++g) { const v4u w = *(const GAS v4u*)(pan + pg8::atile_off(m & 255, g * 32 + c4 * 8));
                    const f32x4 g0 = *(const f32x4*)(final_g + g * 32 + c4 * 8), g1 = *(const f32x4*)(final_g + g * 32 + c4 * 8 + 4);
                    f32x4 v0 = (f32x4){bflo(w.x), bfhi(w.x), bflo(w.y), bfhi(w.y)} * r * g0, v1 = (f32x4){bflo(w.z), bfhi(w.z), bflo(w.w), bfhi(w.w)} * r * g1;
                    if (dead) { v0 = (f32x4){NAN, NAN, NAN, NAN}; v1 = v0; }
                    *(GAS f32x4*)(orow + g * 32) = v0; *(GAS f32x4*)(orow + g * 32 + 4) = v1; }
            }
        } } else {
            const int l = (ph - 1) / 8, j = (ph - 1) % 8;
            unsigned char* wl = (unsigned char*)(wsb + WS_W + (size_t)l * W_LAYER);
            pg8::rss_t* rowss = WSP(pg8::rss_t, WS_ROWSS);
            if (j == 0) { { PHASE_TID();
                pg8::ProbDense<true> S; S.A = WSP(bf16, WS_HB); S.Bt = (const bf16*)(wl + WO_IN); S.K = DM; S.lda = DM; S.ldb = DM; S.bbatch = 0; S.asliced = false; S.ord.init(MTOK / 256, INC / 256, F.G, F.bx, F.vcu);
                pg8::EpiIn E{WSP(bf16, WS_X + X_Q), WSP(bf16, WS_X + X_K), WSP(bf16, WS_X + X_V), WSP(bf16, WS_X + X_BG), WSP(bf16, WS_X + X_U), rowss + (size_t)(3 * l) * MTOK, WSP(float, WS_CS), WSP(bf16, WS_HALO) + (size_t)l * (128 * 2 * 512)};
                pg8::gemm_phase<pg8::EpiIn, pg8::ProbDense<true>, true, true>(F.lds + RING_OFF, S, E, F.tid);
                if (l == 0) {
                    pg8::ProbKV S2; S2.A = WSP(bf16, WS_MEMN); S2.Bt0 = WSP(bf16, WS_W + WO_KV); S2.lstride = W_LAYER / 2; S2.K = DM; S2.lda = DM; S2.ldb = DM; S2.G = F.G; S2.c = F.bx;
                    pg8::EpiKV E2{WSP(bf16, WS_KV), KV_LAYER / 2};
                    pg8::gemm_phase<pg8::EpiKV, pg8::ProbKV, true, true>(F.lds + RING_OFF, S2, E2, F.tid);
                }
            } } else if (j == 1) { { PHASE_TID();
                for (int bc = F.vcu; bc < NB * 16; bc += F.G) {
                    const int bhc = bc >> 1, b = bhc >> 3, hc = bhc & 7; const int cqk = hc * 64, cv = (hc >> 1) * 128, co = hc * 128;
                    for (int i = 0; i < 4; ++i) { const int qb = (bc & 1) ? ((0x7421 >> (4 * i)) & 15) : ((0x6530 >> (4 * i)) & 15);
                        attn_body::attn_unit128<8>(b, cqk, cv, co, qb, WSP(const attn_body::bf16, WS_X + X_Q), WSP(const attn_body::bf16, WS_X + X_K), WSP(const attn_body::bf16, WS_X + X_V), WSP(attn_body::bf16, WS_X + X_O), (char*)lds + RING_OFF, F.tid); }
                }
                const bf16* KVl = WSP(bf16, WS_KV) + (size_t)l * (KV_LAYER / 2);
                { pg8::ProbAbsorb S; S.Kp = KVl; S.Vp = KVl + (size_t)4096 * 1024; S.Wq = (const bf16*)(wl + WO_QG); S.Wo = (const bf16*)(wl + WO_O); S.K = 256; S.lda = DM; S.ldb = DM; S.G = F.G; S.c = F.vcu;
                  pg8::EpiAbsorb E{WSP(bf16, WS_WQK), WSP(bf16, WS_VWO)};
                  pg8::gemm_phase<pg8::EpiAbsorb, pg8::ProbAbsorb, true, true>(F.lds + RING_OFF, S, E, F.tid); }
            } } else if (j == 2) { { PHASE_TID();
                const float lambda_init = (l == 0) ? 0.2f : 0.35550906759f;
                const float d1 = wave_sum(INP(5)[l * 64 + F.lane] * INP(6)[l * 64 + F.lane]), d2 = wave_sum(INP(7)[l * 64 + F.lane] * INP(8)[l * 64 + F.lane]);
                const float lam = expf(d1) - expf(d2) + lambda_init;
                const int lane = F.lane, hh = lane >> 4, vhalf = (lane >> 3) & 1, dd = (lane & 7) * 8;
                const int c0col = (hh * 4 + vhalf) * 64 + dd, c1col = (hh * 4 + 2 + vhalf) * 64 + dd;
                const float* subln_g = INP(9); const float* conv_w = INP(10);
                const bf16* XO = WSP(bf16, WS_X + X_O); const bf16* XU = WSP(bf16, WS_X + X_U); const bf16* XBG = WSP(bf16, WS_X + X_BG); bf16* XMIX = WSP(bf16, WS_X + X_MIX);
                float sg[8], cw0[8], cw1[8], cw2[8];
#pragma unroll
                for (int jj = 0; jj < 8; ++jj) { sg[jj] = subln_g[l * 128 + (lane & 15) * 8 + jj] * (1.0f - lambda_init); cw0[jj] = conv_w[(l * 3 + 0) * 512 + lane * 8 + jj]; cw1[jj] = conv_w[(l * 3 + 1) * 512 + lane * 8 + jj]; cw2[jj] = conv_w[(l * 3 + 2) * 512 + lane * 8 + jj]; }
                for (int ch = gw; ch < MTOK / 16; ch += NGW) {
                    const int t0 = ch * 16; float u1[8], u2[8];
                    if ((t0 & (SEQ - 1)) == 0) {
#pragma unroll
                        for (int jj = 0; jj < 8; ++jj) { u1[jj] = 0.f; u2[jj] = 0.f; }
                    } else {
                        const bool fp_ = (t0 & 255) == 0; const bf16* hp_ = WSP(bf16, WS_HALO) + (size_t)l * (128 * 2 * 512) + (size_t)((t0 >> 8) - 1) * 1024 + lane * 8;
                        const v4u a = fp_ ? *(const v4u*)(hp_ + 512) : *(const v4u*)(XU + pg8::xrow(t0 - 1, 512) + lane * 8), b = fp_ ? *(const v4u*)(hp_) : *(const v4u*)(XU + pg8::xrow(t0 - 2, 512) + lane * 8);
                        u1[0] = bflo(a.x); u1[1] = bfhi(a.x); u1[2] = bflo(a.y); u1[3] = bfhi(a.y); u1[4] = bflo(a.z); u1[5] = bfhi(a.z); u1[6] = bflo(a.w); u1[7] = bfhi(a.w);
                        u2[0] = bflo(b.x); u2[1] = bfhi(b.x); u2[2] = bflo(b.y); u2[3] = bfhi(b.y); u2[4] = bflo(b.z); u2[5] = bfhi(b.z); u2[6] = bflo(b.w); u2[7] = bfhi(b.w);
                    }
#pragma unroll 4
                    for (int tt = 0; tt < 16; ++tt) { const size_t t5 = pg8::xrow(t0 + tt, 512), t = pg8::xrow(t0 + tt, 1024);
                        const v4u o0 = *(const v4u*)(XO + t + c0col), o1 = *(const v4u*)(XO + t + c1col), uu = *(const v4u*)(XU + t5 + lane * 8), bg = *(const v4u*)(XBG + t5 + lane * 8);
                        float d[8];
                        d[0] = bflo(o0.x) - lam * bflo(o1.x); d[1] = bfhi(o0.x) - lam * bfhi(o1.x); d[2] = bflo(o0.y) - lam * bflo(o1.y); d[3] = bfhi(o0.y) - lam * bfhi(o1.y);
                        d[4] = bflo(o0.z) - lam * bflo(o1.z); d[5] = bfhi(o0.z) - lam * bfhi(o1.z); d[6] = bflo(o0.w) - lam * bflo(o1.w); d[7] = bfhi(o0.w) - lam * bfhi(o1.w);
                        float ss = (d[0] * d[0] + d[1] * d[1]) + (d[2] * d[2] + d[3] * d[3]) + (d[4] * d[4] + d[5] * d[5]) + (d[6] * d[6] + d[7] * d[7]);
                        ss += shx(ss, 1); ss += shx(ss, 2); ss += shx(ss, 4); ss += shx(ss, 8);
                        const float r = __builtin_amdgcn_rsqf(ss * (1.0f / 128.0f) + SUBLN_EPS);
                        v4u oa; oa.x = pk2(d[0] * r * sg[0], d[1] * r * sg[1]); oa.y = pk2(d[2] * r * sg[2], d[3] * r * sg[3]); oa.z = pk2(d[4] * r * sg[4], d[5] * r * sg[5]); oa.w = pk2(d[6] * r * sg[6], d[7] * r * sg[7]);
                        float uc[8], bb[8], y[8];
                        uc[0] = bflo(uu.x); uc[1] = bfhi(uu.x); uc[2] = bflo(uu.y); uc[3] = bfhi(uu.y); uc[4] = bflo(uu.z); uc[5] = bfhi(uu.z); uc[6] = bflo(uu.w); uc[7] = bfhi(uu.w);
                        bb[0] = bflo(bg.x); bb[1] = bfhi(bg.x); bb[2] = bflo(bg.y); bb[3] = bfhi(bg.y); bb[4] = bflo(bg.z); bb[5] = bfhi(bg.z); bb[6] = bflo(bg.w); bb[7] = bfhi(bg.w);
#pragma unroll
                        for (int jj = 0; jj < 8; ++jj) { y[jj] = bb[jj] * (cw0[jj] * u2[jj] + cw1[jj] * u1[jj] + cw2[jj] * uc[jj]); u2[jj] = u1[jj]; u1[jj] = uc[jj]; }
                        v4u oc; oc.x = pk2(y[0], y[1]); oc.y = pk2(y[2], y[3]); oc.z = pk2(y[4], y[5]); oc.w = pk2(y[6], y[7]);
                        *(GAS v4u*)(XMIX + t + lane * 8) = oa; *(GAS v4u*)(XMIX + t + 512 + lane * 8) = oc; }
                }
            } } else if (j == 3) { { PHASE_TID();
                pg8::ProbDense<false> S; S.A = WSP(bf16, WS_X + X_MIX); S.Bt = (const bf16*)(wl + WO_MIX); S.K = DM; S.lda = DM; S.ldb = DM; S.bbatch = 0; S.asliced = true; S.ord.init(MTOK / 256, DM / 256, F.G, F.bx, F.vcu);
                pg8::EpiRes E{args.out, WSP(bf16, WS_HB), rowss + (size_t)(3 * l + 1) * MTOK, (rp == nrep - 1) ? 1.0f : 0.0f, rp == nrep - 1, (PG8_LAS float*)(F.lds + EPIX_OFF)};
                pg8::gemm_phase<pg8::EpiRes, pg8::ProbDense<false>, true, true>(F.lds + RING_OFF, S, E, F.tid);
            } } else if (j == 4) { { PHASE_TID();
                pg8::ProbDense<true> S; S.A = WSP(bf16, WS_HB); S.Bt = WSP(bf16, WS_WQK); S.K = DM; S.lda = DM; S.ldb = DM; S.bbatch = (size_t)DM * DM; S.asliced = false; S.ord.init(MTOK / 256, DM / 256, F.G, F.bx, F.vcu);
                pg8::EpiSoftmax E{WSP(bf16, WS_X + X_P), rowss + (size_t)(3 * l + 1) * MTOK, (PG8_LAS pg8::f32x2*)(F.lds + EPIX_OFF)};
                pg8::gemm_phase<pg8::EpiSoftmax, pg8::ProbDense<true>, true, true>(F.lds + RING_OFF, S, E, F.tid);
            } } else if (j == 5) { { PHASE_TID();
                pg8::ProbDense<true> S; S.A = WSP(bf16, WS_X + X_P); S.Bt = WSP(bf16, WS_VWO); S.K = DM; S.lda = DM; S.ldb = DM; S.bbatch = (size_t)DM * DM; S.asliced = true; S.ord.init(MTOK / 256, DM / 256, F.G, F.bx, F.vcu);
                pg8::EpiRes E{args.out, WSP(bf16, WS_HB), rowss + (size_t)(3 * l + 2) * MTOK, (rp == nrep - 1) ? 1.0f : 0.0f, rp == nrep - 1, (PG8_LAS float*)(F.lds + EPIX_OFF)};
                pg8::gemm_phase<pg8::EpiRes, pg8::ProbDense<true>, true, true>(F.lds + RING_OFF, S, E, F.tid);
            } } else if (j == 6) { { PHASE_TID();
                pg8::ProbDense<true> S; S.A = WSP(bf16, WS_HB); S.Bt = (const bf16*)(wl + WO_1); S.K = DM; S.lda = DM; S.ldb = DM; S.bbatch = 0; S.asliced = false; S.ord.init(MTOK / 256, FF / 256, F.G, F.bx, F.vcu);
                pg8::EpiRelu2 E{WSP(bf16, WS_X + X_F), rowss + (size_t)(3 * l + 2) * MTOK};
                pg8::gemm_phase<pg8::EpiRelu2, pg8::ProbDense<true>, true, true>(F.lds + RING_OFF, S, E, F.tid);
            } } else { { PHASE_TID();
                pg8::ProbDense<true> S; S.A = WSP(bf16, WS_X + X_F); S.Bt = (const bf16*)(wl + WO_2); S.K = FF; S.lda = FF; S.ldb = FF; S.bbatch = 0; S.asliced = true; S.ord.init(MTOK / 256, DM / 256, F.G, F.bx, F.vcu);
                pg8::EpiRes E{args.out, WSP(bf16, WS_HB), rowss + (size_t)(3 * l + 3) * MTOK, (rp == nrep - 1) ? 1.0f : 0.0f, rp == nrep - 1, (PG8_LAS float*)(F.lds + EPIX_OFF)};
                pg8::gemm_phase<pg8::EpiRes, pg8::ProbDense<true>, true, true>(F.lds + RING_OFF, S, E, F.tid);
            } }
        }
      }
        GAS unsigned char* wsb = (GAS unsigned char*)args.ws;
        if (!MK_PER_PHASE && ph0 + 1 < args.ph_hi) { bar.bar = WSP(unsigned, WS_CTL) + CW_BAR; unsigned on2_ = ~0u; asm volatile("" : "+s"(on2_)); const int ln_ = __builtin_amdgcn_mbcnt_hi(on2_, __builtin_amdgcn_mbcnt_lo(on2_, 0u)); const bool leader = (wave0 == 0 && ln_ == 0);
            if (false) {
            } else if (local_ok) {
                const int js_ = (ph0 - 1) % 8; int vc_ = (blockIdx.x % 8) * 32 + blockIdx.x / 8; asm volatile("" : "+s"(vc_));
                if (js_ >= 2) pair_barrier(bar, leader, vc_ >> 2); else xcc_barrier(bar, leader);
            } else xcd_barrier(bar, leader); }
    }
}

extern "C" void kernel_launch(void* const* d_in, const int* in_sizes, int n_in, void* d_out, int out_size, void* d_ws, size_t ws_size, hipStream_t stream) {
    static int grid = 0;
    if (grid == 0) {
        if (n_in != 21 || in_sizes[0] != MTOK * DM || out_size != MTOK * DM || ws_size < WS_END) { fprintf(stderr, "kernel_launch: unexpected shapes (n_in %d, in0 %d, out %d, ws %zu); nothing launched\n", n_in, n_in > 0 ? in_sizes[0] : -1, out_size, ws_size); grid = -1; return; }
        int dev = 0, cus = 0, per_cu = 0;
        if (hipGetDevice(&dev) != hipSuccess || hipDeviceGetAttribute(&cus, hipDeviceAttributeMultiprocessorCount, dev) != hipSuccess) { grid = -1; return; }
        if (hipFuncSetAttribute((const void*)fwd_kernel, hipFuncAttributeMaxDynamicSharedMemorySize, LDS_BYTES) != hipSuccess) { fprintf(stderr, "kernel_launch: hipFuncSetAttribute failed\n"); grid = -1; return; }
        if (hipOccupancyMaxActiveBlocksPerMultiprocessor(&per_cu, (const void*)fwd_kernel, NWAVES * 64, LDS_BYTES) != hipSuccess || per_cu < 1) { fprintf(stderr, "kernel_launch: occupancy query reports %d blocks per CU\n", per_cu); }
        (void)hipGetLastError();
        grid = cus;
    }
    if (grid < 0) return;
    (void)hipMemsetAsync((char*)d_ws + WS_CTL, 0, CTL_ZERO_BYTES, stream);
    Args a{};
    for (int i = 0; i < 21; ++i) a.in[i] = d_in[i];
    a.out = (float*)d_out; a.ws = (unsigned char*)d_ws;
#if MK_PER_PHASE
    for (int p = 0; p < NPH; ++p) { a.ph_lo = p; a.ph_hi = p + 1; a.li = p; hipLaunchKernelGGL(fwd_kernel, dim3(grid), dim3(NWAVES * 64), LDS_BYTES, stream, a); }
#else
    a.ph_lo = 0; a.ph_hi = NPH; a.li = 0;
    hipLaunchKernelGGL(fwd_kernel, dim3(grid), dim3(NWAVES * 64), LDS_BYTES, stream, a);
#endif
}
```
